# Optimizing an MI355X kernel written in HIP

```python
import math
import jax, jax.numpy as jnp
from jax import lax
import numpy as np

D_MODEL = 1024
BATCH = 8
SEQ = 4096
DEPTH = 4

N_MIXERS = 3
HEAD_DIM = 64
ROPE_THETA = 500000.0
ROPE_DIM = HEAD_DIM // 4

NSA_HEADS = D_MODEL // HEAD_DIM
NSA_KV_HEADS = 4
NSA_GROUP = NSA_HEADS // NSA_KV_HEADS
CMP_LEN = 32
CMP_STRIDE = 16
CMP_HIDDEN = 256
SEL_LEN = 64
SEL_TOPN = 16
NSA_WINDOW = 512
NSA_QBLOCK = 32
FORCE_BONUS = 100.0

GLA_HEADS = 4
GLA_DK = D_MODEL // 2 // GLA_HEADS
GLA_DV = D_MODEL // GLA_HEADS
GLA_GATE_RANK = 16
GLA_TAU = 16.0
GLA_CHUNK = 64

DIL_HEADS = D_MODEL // HEAD_DIM
DIL_CONFIGS = ((128, 1), (512, 4), (2048, 16))
DIL_QBLOCK = 64

N_EXPERTS = 64
TOP_K = 8
N_GROUPS = 8
TOPK_GROUPS = 4
D_EXPERT = 256
ROUTED_SCALE = 2.5
MOE_BLOCK = 128

DN_ALPHA = (2.0 * DEPTH) ** 0.25
DN_BETA = (8.0 * DEPTH) ** -0.25
LN_EPS = 1e-5
NEG_INF = -1e30

kernel_name = 'hybrid_nsa_gla_dilated_moe_deepnorm'


def layer_norm(x, g, b):
    xf = x.astype(jnp.float32)
    mu = xf.mean(-1, keepdims=True)
    var = jnp.square(xf - mu).mean(-1, keepdims=True)
    return ((xf - mu) * lax.rsqrt(var + LN_EPS) * g + b).astype(x.dtype)


def partial_rope(x, pos):
    half = ROPE_DIM // 2
    inv = ROPE_THETA ** (-jnp.arange(half, dtype=jnp.float32) * 2.0 / ROPE_DIM)
    ang = pos.astype(jnp.float32)[:, None] * inv[None, :]
    cos = jnp.cos(ang)[None, :, None, :]
    sin = jnp.sin(ang)[None, :, None, :]
    xr = x[..., :ROPE_DIM].astype(jnp.float32)
    x1, x2 = xr[..., :half], xr[..., half:]
    rot = jnp.concatenate([x1 * cos - x2 * sin, x2 * cos + x1 * sin], -1).astype(x.dtype)
    return jnp.concatenate([rot, x[..., ROPE_DIM:]], -1)


def masked_softmax(s, mask, axes):
    s = jnp.where(mask, s.astype(jnp.float32), NEG_INF)
    m = jnp.max(s, axis=axes, keepdims=True)
    p = jnp.exp(s - m) * mask
    den = jnp.sum(p, axis=axes, keepdims=True)
    return p / jnp.maximum(den, 1e-30), m, den


def swiglu(x, w_in, w_out):
    g, u = jnp.split(x @ w_in, 2, axis=-1)
    return (jax.nn.silu(g) * u) @ w_out


def nsa_mixer(x, w_in, w_out, ck_pos, ck_w1, ck_w2, cv_pos, cv_w1, cv_w2):
    B, S, _ = x.shape
    H, KH, G, dh = NSA_HEADS, NSA_KV_HEADS, NSA_GROUP, HEAD_DIM
    kvw = KH * dh
    pos = jnp.arange(S)
    cuts = np.cumsum([H * dh, kvw, kvw, kvw, kvw, kvw, kvw]).tolist()
    q, kc, vc, ks, vs, kw, vw, gl = jnp.split(x @ w_in, cuts, axis=-1)
    q = partial_rope(q.reshape(B, S, H, dh), pos) * dh ** -0.5
    kc = partial_rope(kc.reshape(B, S, KH, dh), pos)
    ks = partial_rope(ks.reshape(B, S, KH, dh), pos)
    kw = partial_rope(kw.reshape(B, S, KH, dh), pos)
    vc, vs, vw = (t.reshape(B, S, KH, dh) for t in (vc, vs, vw))
    gates = jax.nn.sigmoid(gl.astype(jnp.float32)).reshape(B, S, H, 3)

    n_cmp = (S - CMP_LEN) // CMP_STRIDE + 1
    cidx = jnp.arange(n_cmp)[:, None] * CMP_STRIDE + jnp.arange(CMP_LEN)[None, :]

    def compress(t, pos_emb, w1, w2):
        blk = t[:, cidx] + pos_emb[None, None, :, None, :]
        blk = blk.transpose(0, 1, 3, 2, 4).reshape(B, n_cmp, KH, CMP_LEN * dh)
        return jax.nn.gelu(blk @ w1) @ w2

    k_cmp = compress(kc, ck_pos, ck_w1, ck_w2)
    v_cmp = compress(vc, cv_pos, cv_w1, cv_w2)
    cmp_start, cmp_end = cidx[:, 0], cidx[:, -1]

    n_sel = S // SEL_LEN
    top_n = min(SEL_TOPN, n_sel)
    sel_start = jnp.arange(n_sel) * SEL_LEN
    overlap = ((cmp_start[:, None] < sel_start[None, :] + SEL_LEN) &
               (cmp_end[:, None] >= sel_start[None, :])).astype(jnp.float32)
    ks_blk = ks.reshape(B, n_sel, SEL_LEN, KH, dh).transpose(0, 3, 1, 2, 4)
    vs_blk = vs.reshape(B, n_sel, SEL_LEN, KH, dh).transpose(0, 3, 1, 2, 4)
    kw_pad = jnp.pad(kw, ((0, 0), (NSA_WINDOW, 0), (0, 0), (0, 0)))
    vw_pad = jnp.pad(vw, ((0, 0), (NSA_WINDOW, 0), (0, 0), (0, 0)))
    qg = q.reshape(B, S, KH, G, dh)
    bi = jnp.arange(B)[:, None, None, None]
    hi = jnp.arange(KH)[None, None, :, None]
    blk_id = jnp.arange(n_sel)
    Q = NSA_QBLOCK

    def block(q0):
        t = q0 + jnp.arange(Q)
        qb = lax.dynamic_slice_in_dim(qg, q0, Q, axis=1)
        s_c = jnp.einsum('bqkgd,bckd->bqkgc', qb, k_cmp)
        m_c = (cmp_end[None, :] <= t[:, None])[None, :, None, None, :]
        p_c, _, _ = masked_softmax(s_c, m_c, -1)
        o_c = jnp.einsum('bqkgc,bckd->bqkgd', p_c.astype(v_cmp.dtype), v_cmp)
        imp = jnp.einsum('bqkgc,cn->bqkn', p_c, overlap)
        cur = t // SEL_LEN
        allowed = (blk_id[None, :] <= cur[:, None])[None, :, None, :]
        forced = ((blk_id[None, :] == 0) | (blk_id[None, :] == cur[:, None]) |
                  (blk_id[None, :] == cur[:, None] - 1))[None, :, None, :]
        score = jnp.where(allowed, imp + FORCE_BONUS * forced, -1.0)
        _, sel = lax.top_k(score, top_n)
        k_sel = ks_blk[bi, hi, sel]
        v_sel = vs_blk[bi, hi, sel]
        s_s = jnp.einsum('bqkgd,bqknld->bqkgnl', qb, k_sel)
        tok = sel[..., None] * SEL_LEN + jnp.arange(SEL_LEN)
        m_s = (tok <= t[None, :, None, None, None])[:, :, :, None]
        p_s, _, _ = masked_softmax(s_s, m_s, (-2, -1))
        o_s = jnp.einsum('bqkgnl,bqknld->bqkgd', p_s.astype(v_sel.dtype), v_sel)
        kwb = lax.dynamic_slice_in_dim(kw_pad, q0, Q + NSA_WINDOW, axis=1)
        vwb = lax.dynamic_slice_in_dim(vw_pad, q0, Q + NSA_WINDOW, axis=1)
        kpos = q0 - NSA_WINDOW + jnp.arange(Q + NSA_WINDOW)
        dist = t[:, None] - kpos[None, :]
        m_w = ((dist >= 0) & (dist < NSA_WINDOW) & (kpos[None, :] >= 0))[None, :, None, None, :]
        s_w = jnp.einsum('bqkgd,bjkd->bqkgj', qb, kwb)
        p_w, _, _ = masked_softmax(s_w, m_w, -1)
        o_w = jnp.einsum('bqkgj,bjkd->bqkgd', p_w.astype(vwb.dtype), vwb)
        g = lax.dynamic_slice_in_dim(gates, q0, Q, axis=1).reshape(B, Q, KH, G, 3)
        o = g[..., 0:1] * o_c + g[..., 1:2] * o_s + g[..., 2:3] * o_w
        return o.reshape(B, Q, H * dh).astype(x.dtype)

    outs = lax.map(block, jnp.arange(S // Q) * Q)
    o = outs.transpose(1, 0, 2, 3).reshape(B, S, H * dh)
    return o @ w_out


def gla_mixer(x, w_in, w_a2, b_a, norm_g, w_out):
    B, S, _ = x.shape
    H, dk, dv, C = GLA_HEADS, GLA_DK, GLA_DV, GLA_CHUNK
    cuts = [H * dk, 2 * H * dk, 2 * H * dk + H * dv, 2 * H * dk + H * dv + GLA_GATE_RANK]
    q, k, v, a_lr, r = jnp.split(x @ w_in, cuts, axis=-1)
    log_a = jax.nn.log_sigmoid((a_lr @ w_a2 + b_a).astype(jnp.float32)) / GLA_TAU
    N = S // C
    q = q.astype(jnp.float32).reshape(B, N, C, H, dk) * dk ** -0.5
    k = k.astype(jnp.float32).reshape(B, N, C, H, dk)
    v = v.astype(jnp.float32).reshape(B, N, C, H, dv)
    b = jnp.cumsum(log_a.reshape(B, N, C, H, dk), axis=2)
    b_last = b[:, :, -1]
    q_g = q * jnp.exp(b)
    k_g = k * jnp.exp(-b)
    k_d = k * jnp.exp(b_last[:, :, None] - b)
    causal = jnp.tril(jnp.ones((C, C), bool))
    A = jnp.where(causal, jnp.einsum('bnihd,bnjhd->bnhij', q_g, k_g), 0.0)
    o_intra = jnp.einsum('bnhij,bnjhe->bnihe', A, v)
    dS = jnp.einsum('bnchd,bnche->nbhde', k_d, v)
    decay = jnp.exp(b_last).transpose(1, 0, 2, 3)

    def step(state, inp):
        dec, ds = inp
        return dec[..., None] * state + ds, state

    _, s_prev = lax.scan(step, jnp.zeros((B, H, dk, dv), jnp.float32), (decay, dS))
    o_inter = jnp.einsum('bnihd,nbhde->bnihe', q_g, s_prev)
    o = (o_intra + o_inter).reshape(B, S, H, dv)
    o = o * lax.rsqrt(jnp.mean(o * o, -1, keepdims=True) + LN_EPS) * norm_g
    o = o.reshape(B, S, H * dv) * jax.nn.silu(r.astype(jnp.float32))
    return o.astype(x.dtype) @ w_out


def dilated_attention(q, k, v, window, dil):
    B, S, H, dh = q.shape
    L, W = S // dil, window // dil
    bq = math.gcd(L, DIL_QBLOCK)
    qr = q.reshape(B, L, dil, H, dh)
    pad = ((0, 0), (W, 0), (0, 0), (0, 0), (0, 0))
    kp = jnp.pad(k.reshape(B, L, dil, H, dh), pad)
    vp = jnp.pad(v.reshape(B, L, dil, H, dh), pad)

    def block(u0):
        u = u0 + jnp.arange(bq)
        qb = lax.dynamic_slice_in_dim(qr, u0, bq, axis=1)
        kb = lax.dynamic_slice_in_dim(kp, u0, bq + W, axis=1)
        vb = lax.dynamic_slice_in_dim(vp, u0, bq + W, axis=1)
        uk = u0 - W + jnp.arange(bq + W)
        dist = u[:, None] - uk[None, :]
        mask = ((dist >= 0) & (dist <= W) & (uk[None, :] >= 0))[None, None, None]
        s = jnp.einsum('bqrhd,bjrhd->brhqj', qb, kb)
        p, m, den = masked_softmax(s, mask, -1)
        o = jnp.einsum('brhqj,bjrhd->bqrhd', p.astype(vb.dtype), vb)
        lse = (m + jnp.log(den))[..., 0]
        return o, lse.transpose(0, 3, 1, 2)

    o, lse = lax.map(block, jnp.arange(L // bq) * bq)
    o = o.transpose(1, 0, 2, 3, 4, 5).reshape(B, S, H, dh)
    lse = lse.transpose(1, 0, 2, 3, 4).reshape(B, S, H)
    return o, lse


def dilated_mixer(x, w_in, w_out):
    B, S, _ = x.shape
    H, dh = DIL_HEADS, HEAD_DIM
    pos = jnp.arange(S)
    proj = (x @ w_in).reshape(B, S, len(DIL_CONFIGS), 3, H, dh)
    outs, lses = [], []
    for gi, (window, dil) in enumerate(DIL_CONFIGS):
        q = partial_rope(proj[:, :, gi, 0], pos) * dh ** -0.5
        k = partial_rope(proj[:, :, gi, 1], pos)
        o, lse = dilated_attention(q, k, proj[:, :, gi, 2], window, dil)
        outs.append(o.astype(jnp.float32))
        lses.append(lse)
    wts = jax.nn.softmax(jnp.stack(lses, 0), axis=0)
    o = jnp.sum(wts[..., None] * jnp.stack(outs, 0), axis=0)
    return o.reshape(B, S, H * dh).astype(x.dtype) @ w_out


def moe_ffn(x, router_w, router_b, w_in_e, w_out_e, w_in_s, w_out_s):
    B, S, D = x.shape
    N = B * S
    xf = x.reshape(N, D)
    s = jax.nn.sigmoid((xf @ router_w).astype(jnp.float32))
    sb = s + router_b.astype(jnp.float32)
    g_score = lax.top_k(sb.reshape(N, N_GROUPS, -1), 2)[0].sum(-1)
    _, g_idx = lax.top_k(g_score, TOPK_GROUPS)
    g_mask = jnp.any(g_idx[:, :, None] == jnp.arange(N_GROUPS)[None, None, :], axis=1)
    e_mask = jnp.repeat(g_mask, N_EXPERTS // N_GROUPS, axis=1)
    _, e_idx = lax.top_k(jnp.where(e_mask, sb, NEG_INF), TOP_K)
    gate = jnp.take_along_axis(s, e_idx, axis=1)
    gate = gate / jnp.sum(gate, -1, keepdims=True) * ROUTED_SCALE
    NK = N * TOP_K
    flat_e = e_idx.reshape(NK)
    order = jnp.argsort(flat_e)
    e_sorted = flat_e[order]
    counts = jnp.bincount(flat_e, length=N_EXPERTS)
    start = jnp.cumsum(counts) - counts
    padded = (counts + MOE_BLOCK - 1) // MOE_BLOCK * MOE_BLOCK
    pad_end = jnp.cumsum(padded)
    dest = (pad_end - padded)[e_sorted] + jnp.arange(NK) - start[e_sorted]
    n_blk = -(-NK // MOE_BLOCK) + N_EXPERTS
    P = n_blk * MOE_BLOCK
    row_tok = jnp.full((P,), N, jnp.int32).at[dest].set((order // TOP_K).astype(jnp.int32))
    row_gate = jnp.zeros((P,), jnp.float32).at[dest].set(gate.reshape(NK)[order])
    blk_e = jnp.minimum(jnp.searchsorted(pad_end, jnp.arange(n_blk) * MOE_BLOCK, side='right'), N_EXPERTS - 1)
    x_pad = jnp.concatenate([xf, jnp.zeros((1, D), xf.dtype)], 0)

    def expert_block(args):
        tok, e = args
        return swiglu(x_pad[tok], w_in_e[e], w_out_e[e])

    y = lax.map(expert_block, (row_tok.reshape(n_blk, MOE_BLOCK), blk_e))
    y = y.reshape(P, D).astype(jnp.float32) * row_gate[:, None]
    routed = jax.ops.segment_sum(y, row_tok, num_segments=N + 1)[:N]
    out = routed + swiglu(xf, w_in_s, w_out_s).astype(jnp.float32)
    return out.reshape(B, S, D).astype(x.dtype)


def setup_inputs(seed: int = 0) -> dict:
    key = jax.random.key(seed)
    keys = iter(jax.random.split(key, 128))
    D, F, E = D_MODEL, D_EXPERT, N_EXPERTS

    def nrm(shape, scale):
        return jax.random.normal(next(keys), shape, jnp.float32) * scale

    def gain(n):
        return 1.0 + 0.02 * jax.random.normal(next(keys), (n,), jnp.float32)

    inp = {'x': nrm((BATCH, SEQ, D), 1.0)}
    for i in range(DEPTH):
        p = 'l%d_' % i
        kind = i % N_MIXERS
        if kind == 0:
            width = NSA_HEADS * HEAD_DIM
            n_in = width + 6 * NSA_KV_HEADS * HEAD_DIM + 3 * NSA_HEADS
            inp[p + 'nsa_w_in'] = nrm((D, n_in), D ** -0.5)
            inp[p + 'nsa_w_out'] = nrm((width, D), DN_BETA * width ** -0.5)
            for t in ('ck', 'cv'):
                inp[p + 'nsa_' + t + '_pos'] = nrm((CMP_LEN, HEAD_DIM), 0.1)
                inp[p + 'nsa_' + t + '_w1'] = nrm((CMP_LEN * HEAD_DIM, CMP_HIDDEN), (CMP_LEN * HEAD_DIM) ** -0.5)
                inp[p + 'nsa_' + t + '_w2'] = nrm((CMP_HIDDEN, HEAD_DIM), CMP_HIDDEN ** -0.5)
        elif kind == 1:
            hk, hv = GLA_HEADS * GLA_DK, GLA_HEADS * GLA_DV
            inp[p + 'gla_w_in'] = nrm((D, 2 * hk + hv + GLA_GATE_RANK + D), D ** -0.5)
            inp[p + 'gla_w_a2'] = nrm((GLA_GATE_RANK, hk), GLA_GATE_RANK ** -0.5)
            inp[p + 'gla_b_a'] = nrm((hk,), 0.1)
            inp[p + 'gla_norm_g'] = gain(GLA_DV)
            inp[p + 'gla_w_out'] = nrm((hv, D), DN_BETA * hv ** -0.5)
        else:
            width = DIL_HEADS * HEAD_DIM
            inp[p + 'dil_w_in'] = nrm((D, 3 * len(DIL_CONFIGS) * width), D ** -0.5)
            inp[p + 'dil_w_out'] = nrm((width, D), DN_BETA * width ** -0.5)
        inp[p + 'ln1_g'] = gain(D)
        inp[p + 'ln1_b'] = nrm((D,), 0.02)
        inp[p + 'router_w'] = nrm((D, E), D ** -0.5)
        inp[p + 'router_b'] = nrm((E,), 0.01)
        inp[p + 'moe_w_in'] = nrm((E, D, 2 * F), D ** -0.5)
        inp[p + 'moe_w_out'] = nrm((E, F, D), DN_BETA * F ** -0.5)
        inp[p + 'shared_w_in'] = nrm((D, 2 * F), D ** -0.5)
        inp[p + 'shared_w_out'] = nrm((F, D), DN_BETA * F ** -0.5)
        inp[p + 'ln2_g'] = gain(D)
        inp[p + 'ln2_b'] = nrm((D,), 0.02)
    return inp


def reference(x,
              l0_nsa_w_in, l0_nsa_w_out, l0_nsa_ck_pos, l0_nsa_ck_w1, l0_nsa_ck_w2, l0_nsa_cv_pos, l0_nsa_cv_w1, l0_nsa_cv_w2,
              l0_ln1_g, l0_ln1_b, l0_router_w, l0_router_b, l0_moe_w_in, l0_moe_w_out, l0_shared_w_in, l0_shared_w_out, l0_ln2_g, l0_ln2_b,
              l1_gla_w_in, l1_gla_w_a2, l1_gla_b_a, l1_gla_norm_g, l1_gla_w_out,
              l1_ln1_g, l1_ln1_b, l1_router_w, l1_router_b, l1_moe_w_in, l1_moe_w_out, l1_shared_w_in, l1_shared_w_out, l1_ln2_g, l1_ln2_b,
              l2_dil_w_in, l2_dil_w_out,
              l2_ln1_g, l2_ln1_b, l2_router_w, l2_router_b, l2_moe_w_in, l2_moe_w_out, l2_shared_w_in, l2_shared_w_out, l2_ln2_g, l2_ln2_b,
              l3_nsa_w_in, l3_nsa_w_out, l3_nsa_ck_pos, l3_nsa_ck_w1, l3_nsa_ck_w2, l3_nsa_cv_pos, l3_nsa_cv_w1, l3_nsa_cv_w2,
              l3_ln1_g, l3_ln1_b, l3_router_w, l3_router_b, l3_moe_w_in, l3_moe_w_out, l3_shared_w_in, l3_shared_w_out, l3_ln2_g, l3_ln2_b):
    mixer_params = [
        (l0_nsa_w_in, l0_nsa_w_out, l0_nsa_ck_pos, l0_nsa_ck_w1, l0_nsa_ck_w2, l0_nsa_cv_pos, l0_nsa_cv_w1, l0_nsa_cv_w2),
        (l1_gla_w_in, l1_gla_w_a2, l1_gla_b_a, l1_gla_norm_g, l1_gla_w_out),
        (l2_dil_w_in, l2_dil_w_out),
        (l3_nsa_w_in, l3_nsa_w_out, l3_nsa_ck_pos, l3_nsa_ck_w1, l3_nsa_ck_w2, l3_nsa_cv_pos, l3_nsa_cv_w1, l3_nsa_cv_w2),
    ]
    ffn_params = [
        (l0_ln1_g, l0_ln1_b, l0_router_w, l0_router_b, l0_moe_w_in, l0_moe_w_out, l0_shared_w_in, l0_shared_w_out, l0_ln2_g, l0_ln2_b),
        (l1_ln1_g, l1_ln1_b, l1_router_w, l1_router_b, l1_moe_w_in, l1_moe_w_out, l1_shared_w_in, l1_shared_w_out, l1_ln2_g, l1_ln2_b),
        (l2_ln1_g, l2_ln1_b, l2_router_w, l2_router_b, l2_moe_w_in, l2_moe_w_out, l2_shared_w_in, l2_shared_w_out, l2_ln2_g, l2_ln2_b),
        (l3_ln1_g, l3_ln1_b, l3_router_w, l3_router_b, l3_moe_w_in, l3_moe_w_out, l3_shared_w_in, l3_shared_w_out, l3_ln2_g, l3_ln2_b),
    ]
    mixer_fns = (nsa_mixer, gla_mixer, dilated_mixer)
    for i in range(DEPTH):
        h = mixer_fns[i % N_MIXERS](x, *mixer_params[i])
        ln1_g, ln1_b, rw, rb, ewi, ewo, swi, swo, ln2_g, ln2_b = ffn_params[i]
        x = layer_norm(DN_ALPHA * x + h, ln1_g, ln1_b)
        x = layer_norm(DN_ALPHA * x + moe_ffn(x, rw, rb, ewi, ewo, swi, swo), ln2_g, ln2_b)
    return x
```

```cpp
#include <hip/hip_runtime.h>
#include <stdint.h>
#include <stdio.h>

#ifndef DIAG
#define DIAG 0
#endif

typedef unsigned short bf16_t;
typedef short bf16x8 __attribute__((ext_vector_type(8)));
typedef float f32x4 __attribute__((ext_vector_type(4)));
typedef float f32x2 __attribute__((ext_vector_type(2)));
typedef float f32x16 __attribute__((ext_vector_type(16)));
typedef unsigned u32x4 __attribute__((ext_vector_type(4)));
typedef unsigned u32x2 __attribute__((ext_vector_type(2)));
#define LAS __attribute__((address_space(3)))
#define DEV __device__ __forceinline__

constexpr int NTOK = 32768, SEQ = 4096, NB = 8, DM = 1024;
constexpr int NTHR = 512, NWAVE = 8;
constexpr float DN_ALPHA = 1.681792830507429f;
constexpr float LN_EPS = 1e-5f;
constexpr float LOG2E = 1.4426950408889634f;
constexpr float QSCALE = 0.125f * LOG2E;

DEV unsigned cvt_pk_bf16(float lo, float hi) { unsigned r; asm volatile("v_cvt_pk_bf16_f32 %0, %1, %2" : "=v"(r) : "v"(lo), "v"(hi)); return r; }
DEV bf16_t f2bf(float x) { return (bf16_t)(cvt_pk_bf16(x, 0.f) & 0xffffu); }
DEV float bf2f(bf16_t b) { return __uint_as_float(((unsigned)b) << 16); }
DEV float bflo(unsigned w) { return __uint_as_float(w << 16); }
DEV float bfhi(unsigned w) { return __uint_as_float(w & 0xffff0000u); }
DEV float fast_exp2(float x) { return __builtin_amdgcn_exp2f(x); }
DEV float fast_rcp(float x) { return __builtin_amdgcn_rcpf(x); }
DEV float sigmoidf_(float x) { return fast_rcp(1.f + fast_exp2(-x * LOG2E)); }
DEV float siluf_(float x) { return x * sigmoidf_(x); }
DEV float gelu_tanh(float x) {
    const float u = 0.7978845608028654f * (x + 0.044715f * x * x * x);
    const float t = 1.f - 2.f * fast_rcp(1.f + fast_exp2(2.f * LOG2E * u));
    return 0.5f * x * (1.f + t);
}
template <int X> DEV float swz_xor(float v) { return __int_as_float(__builtin_amdgcn_ds_swizzle(__float_as_int(v), 0x1F | (X << 10))); }
template <int X> DEV int swz_xor_i(int v) { return __builtin_amdgcn_ds_swizzle(v, 0x1F | (X << 10)); }
DEV float bperm_f(int srclane, float v) { return __int_as_float(__builtin_amdgcn_ds_bpermute(srclane << 2, __float_as_int(v))); }
DEV int bperm_i(int srclane, int v) { return __builtin_amdgcn_ds_bpermute(srclane << 2, v); }
DEV float xor32_f(float v, int lane) { return bperm_f(lane ^ 32, v); }
DEV float wave_sum(float v, int lane) {
    v += swz_xor<1>(v); v += swz_xor<2>(v); v += swz_xor<4>(v); v += swz_xor<8>(v); v += swz_xor<16>(v); v += xor32_f(v, lane);
    return v;
}

#define XB_TMO      128
#define XB_XCNT(j)  (256  + 64 * (j))
#define XB_XSUB(j)  (1280 + 64 * (j))
#define XB_XGEN(j)  (2304 + 64 * (j))
#define XB_TOP      3328
#define XB_TOPGEN   3392
#define XCD_BAR_WORDS 3456
#define XB_SPIN_CAP (1u << 18)

__device__ __forceinline__ unsigned xb_ld(unsigned* p)              { return __hip_atomic_load(p, __ATOMIC_RELAXED, __HIP_MEMORY_SCOPE_AGENT); }
__device__ __forceinline__ unsigned xb_add(unsigned* p, unsigned v) { return __hip_atomic_fetch_add(p, v, __ATOMIC_RELAXED, __HIP_MEMORY_SCOPE_AGENT); }
__device__ __forceinline__ unsigned xb_xcc_id() { return (unsigned)__builtin_amdgcn_s_getreg((3 << 11) | 20) & 0xFu; }
#define XB_SPIN(cond, bar) do { unsigned _sp = 0; while (cond) { __builtin_amdgcn_s_sleep(1); \
    if ((++_sp & 255u) == 0u) { if (xb_ld(&(bar)[XB_TMO])) break; if (_sp > XB_SPIN_CAP) { atomicAdd(&(bar)[XB_TMO], 1u); break; } } } } while (0)

struct XcdBarrier { unsigned* bar; unsigned x; volatile LAS unsigned* st; };

__device__ __forceinline__ XcdBarrier xcd_barrier_post(unsigned* bar, volatile LAS unsigned* st) {
    XcdBarrier b; b.bar = bar; b.x = xb_xcc_id(); b.st = st;
    if (threadIdx.x == 0) (void)xb_add(&bar[XB_XCNT(b.x)], 1u);
    return b;
}
__device__ __forceinline__ void xcd_barrier_complete(unsigned* bar, unsigned x, unsigned& nloc, unsigned& nx) {
    const unsigned G = gridDim.x * gridDim.y * gridDim.z;
    unsigned sum, cnt, mine, sp = 0u;
    for (;;) {
        sum = 0u; cnt = 0u; mine = 0u;
#pragma unroll
        for (unsigned j = 0; j < 16; ++j) { const unsigned c = xb_ld(&bar[XB_XCNT(j)]); sum += c; cnt += (c > 0u) ? 1u : 0u; mine = (j == x) ? c : mine; }
        if (sum == G) break;
        __builtin_amdgcn_s_sleep(1);
        if ((++sp & 255u) == 0u) { if (xb_ld(&bar[XB_TMO])) break; if (sp > XB_SPIN_CAP) { atomicAdd(&bar[XB_TMO], 1u); break; } }
    }
    nloc = mine > 0u ? mine : 1u; nx = cnt > 0u ? cnt : 1u;
}
__device__ __forceinline__ void xcd_barrier(const XcdBarrier& b) {
    asm volatile("s_waitcnt vmcnt(0)" ::: "memory");
    __syncthreads();
    if (threadIdx.x == 0) {
        unsigned* bar = b.bar;
        __builtin_amdgcn_s_waitcnt(0);
        unsigned nloc = b.st[0], nx = b.st[1];
        if (nloc == 0u) { xcd_barrier_complete(bar, b.x, nloc, nx); b.st[0] = nloc; b.st[1] = nx; }
        const unsigned old = xb_add(&bar[XB_XSUB(b.x)], 1u);
        const unsigned gen = old / nloc;
        if (old + 1u == (gen + 1u) * nloc) {
            __builtin_amdgcn_fence(__ATOMIC_RELEASE, "agent");
            asm volatile("s_waitcnt vmcnt(0)" ::: "memory");
            const unsigned og = xb_add(&bar[XB_TOP], 1u);
            const unsigned tg = og / nx;
            if (og + 1u == (tg + 1u) * nx) xb_add(&bar[XB_TOPGEN], 1u);
            else XB_SPIN(xb_ld(&bar[XB_TOPGEN]) == tg, bar);
            __builtin_amdgcn_fence(__ATOMIC_ACQUIRE, "agent");
            xb_add(&bar[XB_XGEN(b.x)], 1u);
            asm volatile("s_waitcnt vmcnt(0)" ::: "memory");
        } else {
            XB_SPIN(xb_ld(&bar[XB_XGEN(b.x)]) == gen, bar);
            __builtin_amdgcn_fence(__ATOMIC_ACQUIRE, "agent");
            asm volatile("s_waitcnt vmcnt(0)" ::: "memory");
        }
    }
    __syncthreads();
}

constexpr size_t MB = 1024ull * 1024ull;
constexpr size_t WS_CTL = 0;
constexpr int    CW_BAR = 0;
constexpr int    CW_DIAG = 4096;
constexpr size_t CTL_BYTES = 64 * 1024;
constexpr size_t WS_ROPE = 64 * 1024;
constexpr size_t WS_META = WS_ROPE + 256 * 1024;
constexpr int    META_CNT = 0, META_SEG = 256 * 64, META_NMT = META_SEG + 80, META_TILE = META_NMT + 16;
constexpr size_t WS_BIAS = WS_META + 128 * 1024;
constexpr size_t WS_XB = 1 * MB;
constexpr size_t XB_BYTES = (size_t)(NTOK + 256) * DM * 2;
constexpr size_t WS_WMIX = WS_XB + ((XB_BYTES + MB - 1) / MB) * MB;
constexpr size_t WMIX_BYTES = 24 * MB;
constexpr size_t WS_WMOE = WS_WMIX + WMIX_BYTES;
constexpr size_t WE1_ELEMS = (size_t)65 * 512 * 1024;
constexpr size_t WE2_ELEMS = (size_t)65 * 1024 * 256;
constexpr size_t WS_WE1 = WS_WMOE, WS_WE2 = WS_WE1 + WE1_ELEMS * 2, WS_WR = WS_WE2 + WE2_ELEMS * 2;
constexpr size_t WMOE_BYTES = ((WE1_ELEMS + WE2_ELEMS) * 2 + 64 * 1024 * 2 + MB - 1) / MB * MB;
constexpr size_t WS_ACT = WS_WMOE + WMOE_BYTES;

constexpr int    MOE_ROWS_R = 262144 + 64 * 256;
constexpr int    MOE_ROWS = MOE_ROWS_R + NTOK;
constexpr size_t A_PE = WS_ACT, A_PG = A_PE + 1 * MB, A_PR = A_PG + 1 * MB, A_POS = A_PR + 1 * MB;
constexpr size_t A_ROWTOK = A_POS + 1 * MB, A_ROWGATE = A_ROWTOK + 2 * MB;
constexpr size_t A_H = A_ROWGATE + 2 * MB;
constexpr size_t A_Y = A_H + ((size_t)MOE_ROWS * 256 * 2 + MB - 1) / MB * MB;
constexpr size_t MOE_END = A_Y + (size_t)MOE_ROWS_R * 1024 * 2;
constexpr size_t N_Q = WS_ACT;
constexpr size_t N_KCVC = N_Q + 64 * MB;
constexpr size_t N_KS = N_KCVC + 32 * MB, N_KW = N_KS + 16 * MB;
constexpr size_t N_VTS = N_KW + 16 * MB, N_VTW = N_VTS + 16 * MB;
constexpr size_t N_GATE = N_VTW + 16 * MB;
constexpr size_t N_HC = N_GATE + 8 * MB;
constexpr size_t N_KCMP = N_HC + 8 * MB;
constexpr size_t N_VCMPT = N_KCMP + 1 * MB;
constexpr size_t N_O = N_VCMPT + 1 * MB;
constexpr size_t NSA_END = N_O + 64 * MB;
constexpr size_t G_Q = WS_ACT, G_K = G_Q + 32 * MB;
constexpr size_t G_R = G_K + 32 * MB;
constexpr size_t G_ALR = G_R + 64 * MB;
constexpr size_t G_VT = G_ALR + 2 * MB;
constexpr size_t G_OI = G_VT + 64 * MB;
constexpr size_t G_QG = G_OI + 128 * MB;
constexpr size_t G_DST = G_QG + 32 * MB;
constexpr size_t G_DEC = G_DST + 128 * MB;
constexpr size_t G_O = G_DEC + 1 * MB;
constexpr size_t GLA_END = G_O + 64 * MB;
constexpr size_t D_Q = WS_ACT, D_K = D_Q + 192 * MB;
constexpr size_t D_VT = D_K + 192 * MB;
constexpr size_t D_OG = D_VT + 192 * MB;
constexpr size_t D_LSE = D_OG + 192 * MB;
constexpr size_t D_O = D_Q;
constexpr size_t DIL_END = D_LSE + 6 * MB;
constexpr size_t WS_NEED = (MOE_END > DIL_END ? MOE_END : DIL_END) > (NSA_END > GLA_END ? NSA_END : GLA_END) ? (MOE_END > DIL_END ? MOE_END : DIL_END) : (NSA_END > GLA_END ? NSA_END : GLA_END);

constexpr size_t NW_A = 0, NW_V = NW_A + (size_t)2304 * 1024, NW_W1 = NW_V + (size_t)512 * 1024, NW_OUT = NW_W1 + (size_t)2 * 256 * 2048, NW_W2 = NW_OUT + (size_t)1024 * 1024;
constexpr size_t GW_A = 0, GW_V = GW_A + (size_t)2304 * 1024, GW_OUT = GW_V + (size_t)1024 * 1024;
constexpr size_t DW_A = 0, DW_V = DW_A + (size_t)6144 * 1024, DW_OUT = DW_V + (size_t)3072 * 1024;
static_assert((DW_OUT + 1024 * 1024) * 2 <= WMIX_BYTES, "WMIX too small");

constexpr int LDS_MAIN = 131072;
constexpr int LDS_MISC = LDS_MAIN;
constexpr int LDS_DESC = LDS_MISC + 1024;
constexpr int LDS_BYTES = LDS_MAIN + 1024 + 16 * 192;

struct Args { const float* in[64]; float* out; unsigned char* ws; };

struct Ctx {
    LAS unsigned char* lds;
    unsigned char* ws;
    float* xf;
    int tid, lane, wave, G, vcu;
    DEV const float* in(int i) const { return ((const float* const LAS*)(lds + LDS_MISC + 64))[i]; }
    template <class T> DEV T* w(size_t off) const { return (T*)(ws + off); }
};
DEV unsigned long long uni64(unsigned long long v) {
    const unsigned lo = __builtin_amdgcn_readfirstlane((unsigned)v), hi = __builtin_amdgcn_readfirstlane((unsigned)(v >> 32));
    return ((unsigned long long)hi << 32) | lo;
}
DEV int uni(int v) { return __builtin_amdgcn_readfirstlane(v); }
template <class T> DEV T* unip(T* p) { return (T*)uni64((unsigned long long)p); }
DEV Ctx make_ctx() {
    extern __shared__ __attribute__((aligned(16))) unsigned char lds_raw[];
    Ctx c;
    { unsigned lb = 0u; asm volatile("" : "+s"(lb)); c.lds = (LAS unsigned char*)lds_raw + lb; }
    {
        unsigned long long w = uni64((unsigned long long)*(unsigned char* LAS*)(c.lds + LDS_MISC + 16)), o = uni64((unsigned long long)*(float* LAS*)(c.lds + LDS_MISC + 24));
        asm volatile("" : "+s"(w), "+s"(o));
        c.ws = (unsigned char*)w; c.xf = (float*)o;
    }
    int tz_ = threadIdx.x; asm volatile("" : "+v"(tz_));
    c.tid = tz_; c.lane = c.tid & 63; c.wave = uni(c.tid >> 6);
    { int g = gridDim.x, bx = blockIdx.x; asm volatile("" : "+s"(g), "+s"(bx)); c.G = g; c.vcu = (g % 8 == 0) ? (bx % 8) * (g / 8) + bx / 8 : bx; }
    return c;
}

struct ConvJob {
    const float* src; bf16_t* dst; int ldn, K, ntn, nvalid, nbatch; size_t sbatch, dbatch; int mode; int col0;
};
DEV int conv_srccol(const ConvJob& j, int nt) {
    const int n = nt * 64;
    switch (j.mode) {
    default: return j.col0 + n;
    case 1: { const int pn = n >> 8, half = (n >> 7) & 1, jj = n & 127; return half * 256 + pn * 128 + jj; }
    }
}
__device__ void conv_run(const ConvJob& j) {
    const Ctx c = make_ctx();
    LAS bf16_t* T = (LAS bf16_t*)c.lds;
    const int nkt = j.K >> 6, per = j.ntn * nkt, total = per * j.nbatch;
    const int kr = c.tid >> 4, nc4 = (c.tid & 15) * 4;
    const int wn = c.tid >> 3, wk = (c.tid & 7) * 8;
    for (int t = c.vcu; t < total; t += c.G) {
        const int b = t / per, r = t - b * per, nt = r / nkt, kt = r - nt * nkt;
        const float* s = j.src + (size_t)b * j.sbatch + (size_t)(kt * 64) * j.ldn + conv_srccol(j, nt);
        const int nbase = nt * 64;
#pragma unroll
        for (int i = 0; i < 2; ++i) {
            f32x4 v = {0.f, 0.f, 0.f, 0.f};
            if (nbase + nc4 < j.nvalid) v = *(const f32x4*)(s + (size_t)(kr + 32 * i) * j.ldn + nc4);
            const int k = kr + 32 * i;
            T[(nc4 + 0) * 72 + k] = f2bf(v[0]); T[(nc4 + 1) * 72 + k] = f2bf(v[1]);
            T[(nc4 + 2) * 72 + k] = f2bf(v[2]); T[(nc4 + 3) * 72 + k] = f2bf(v[3]);
        }
        __syncthreads();
        const u32x4 o = *(const LAS u32x4*)(T + wn * 72 + wk);
        *(u32x4*)(j.dst + (size_t)b * j.dbatch + (size_t)(nbase + wn) * j.K + kt * 64 + wk) = o;
        __syncthreads();
    }
}
DEV void conv(const float* src, int ldn, int col0, int nvalid, int nrows_pad, int K, bf16_t* dst) {
    ConvJob j; j.src = src; j.dst = dst; j.ldn = ldn; j.K = K; j.ntn = nrows_pad / 64; j.nvalid = nvalid; j.nbatch = 1; j.sbatch = 0; j.dbatch = 0; j.mode = 0; j.col0 = col0;
    conv_run(j);
}

__device__ void conv_router(const float* rw, bf16_t* dst) {
    const Ctx c = make_ctx();
    for (int idx = c.vcu * NTHR + c.tid; idx < 64 * 1024; idx += c.G * NTHR) {
        const int i = idx >> 10, k = idx & 1023;
        const int e = 16 * ((i >> 2) & 3) + 4 * (i >> 4) + (i & 3);
        dst[idx] = f2bf(rw[(size_t)k * 64 + e]);
    }
}

DEV void sincos_d(double x, double& s, double& c) {
    const double k = rint(x * 0.6366197723675814);
    const double r = (x - k * 1.5707963267948966) - k * 6.123233995736766e-17;
    const double r2 = r * r;
    double sp = -7.647163731819816e-13; sp = sp * r2 + 1.605904383682161e-10; sp = sp * r2 - 2.505210838544172e-08; sp = sp * r2 + 2.755731922398589e-06;
    sp = sp * r2 - 1.984126984126984e-04; sp = sp * r2 + 8.333333333333333e-03; sp = sp * r2 - 1.666666666666667e-01; sp = r + r * r2 * sp;
    double cp = -1.147074559772972e-11; cp = cp * r2 + 2.087675698786810e-09; cp = cp * r2 - 2.755731922398589e-07; cp = cp * r2 + 2.480158730158730e-05;
    cp = cp * r2 - 1.388888888888889e-03; cp = cp * r2 + 4.166666666666666e-02; cp = cp * r2 - 0.5; cp = 1.0 + r2 * cp;
    const int q = ((int)k) & 3;
    s = (q == 0) ? sp : (q == 1) ? cp : (q == 2) ? -sp : -cp;
    c = (q == 0) ? cp : (q == 1) ? -sp : (q == 2) ? -cp : sp;
}
__device__ void rope_table() {
    const Ctx c = make_ctx();
    float* ct = c.w<float>(WS_ROPE); float* st = ct + 4096 * 8;
    const float inv[8] = {1.0f, 0.19393656f, 0.037611387f, 0.0072942254f, 0.0014146171f, 0.00027434599f, 5.3205722e-05f, 1.0318535e-05f};
    for (int idx = c.vcu * NTHR + c.tid; idx < 4096 * 8; idx += c.G * NTHR) {
        const int pos = idx >> 3, i = idx & 7;
        float iv = inv[0];
#pragma unroll
        for (int q = 1; q < 8; ++q) iv = (i == q) ? inv[q] : iv;
        const float ang = (float)pos * iv;
        double s, co; sincos_d((double)ang, s, co);
        ct[idx] = (float)co; st[idx] = (float)s;
    }
}

__device__ void prologue() {
    const Ctx c = make_ctx();
    const float* x = c.in(0);
    bf16_t* xb = c.w<bf16_t>(WS_XB);
    const size_t n4 = (size_t)NTOK * DM / 4;
    for (size_t i = (size_t)c.vcu * NTHR + c.tid; i < n4; i += (size_t)c.G * NTHR) {
        const f32x4 v = ((const f32x4*)x)[i];
        ((f32x4*)c.xf)[i] = v;
        u32x2 o; o.x = cvt_pk_bf16(v[0], v[1]); o.y = cvt_pk_bf16(v[2], v[3]);
        ((u32x2*)xb)[i] = o;
    }
    for (int i = c.vcu * NTHR + c.tid; i < 256 * DM / 2; i += c.G * NTHR) ((unsigned*)(xb + (size_t)NTOK * DM))[i] = 0u;
    rope_table();
}

template <int MODE>
__device__ void ln_phase(const float* g, const float* b) {
    const Ctx c = make_ctx();
    bf16_t* xb = c.w<bf16_t>(WS_XB);
    const int* pos = c.w<int>(A_POS);
    const bf16_t* Y = c.w<bf16_t>(A_Y);
    f32x4 gv[4], bv[4];
#pragma unroll
    for (int j = 0; j < 4; ++j) { gv[j] = *(const f32x4*)(g + j * 256 + c.lane * 4); bv[j] = *(const f32x4*)(b + j * 256 + c.lane * 4); }
    for (int row = c.vcu * NWAVE + c.wave; row < NTOK; row += c.G * NWAVE) {
        float* xr = c.xf + (size_t)row * DM;
        f32x4 v[4];
#pragma unroll
        for (int j = 0; j < 4; ++j) v[j] = *(const f32x4*)(xr + j * 256 + c.lane * 4);
        if (MODE == 1) {
            int p[8];
#pragma unroll
            for (int k = 0; k < 8; ++k) p[k] = pos[row * 8 + k];
#pragma unroll
            for (int k = 0; k < 8; ++k) {
                const bf16_t* yr = Y + (size_t)p[k] * DM;
#pragma unroll
                for (int j = 0; j < 4; ++j) {
                    const u32x2 w = *(const u32x2*)(yr + j * 256 + c.lane * 4);
                    v[j][0] += bflo(w.x); v[j][1] += bfhi(w.x); v[j][2] += bflo(w.y); v[j][3] += bfhi(w.y);
                }
            }
        }
        float s = 0.f;
#pragma unroll
        for (int j = 0; j < 4; ++j) s += (v[j][0] + v[j][1]) + (v[j][2] + v[j][3]);
        const float mu = wave_sum(s, c.lane) * (1.f / 1024.f);
        float q = 0.f;
#pragma unroll
        for (int j = 0; j < 4; ++j) { v[j] = v[j] - mu; q += (v[j][0] * v[j][0] + v[j][1] * v[j][1]) + (v[j][2] * v[j][2] + v[j][3] * v[j][3]); }
        const float rs = __builtin_amdgcn_rsqf(wave_sum(q, c.lane) * (1.f / 1024.f) + LN_EPS);
#pragma unroll
        for (int j = 0; j < 4; ++j) {
            const f32x4 o = v[j] * rs * gv[j] + bv[j];
            *(f32x4*)(xr + j * 256 + c.lane * 4) = o;
            u32x2 w; w.x = cvt_pk_bf16(o[0], o[1]); w.y = cvt_pk_bf16(o[2], o[3]);
            *(u32x2*)(xb + (size_t)row * DM + j * 256 + c.lane * 4) = w;
        }
    }
}

constexpr int BM = 256, BK = 64, HALF = 128, HT = HALF * BK;

enum { EPI_NSA_A = 1, EPI_NSA_V, EPI_CMP1, EPI_WOUT, EPI_GLA_A, EPI_GLA_V, EPI_DIL_A, EPI_DIL_V, EPI_MOE1, EPI_MOE2 };
enum { AM_ID = 0, AM_IDX = 1, AM_CMP = 2 };
enum { BM_ID = 0, BM_DIL = 1, BM_EXP = 2 };

struct GemmDesc {
    const bf16_t* A; const bf16_t* Bt;
    int lda, ldb, K, kstepA;
    int nM, nN; const int* nM_ptr;
    int amode; const int* aidx;
    int bmode; const int* tile_e; size_t bstride;
    int epi;
    void* o0; void* o1; void* o2; void* o3;
    const float* f0; const float* f1;
};

#ifndef GEMM_LINKAGE
#define GEMM_LINKAGE __device__ __forceinline__
#endif
DEV GemmDesc load_desc(const Ctx& c, int slot) {
    const GemmDesc* s = (const GemmDesc*)(unsigned char*)(c.lds + LDS_DESC + slot * 192);
    GemmDesc d;
    d.A = unip(s->A); d.Bt = unip(s->Bt); d.lda = uni(s->lda); d.ldb = uni(s->ldb); d.K = uni(s->K); d.kstepA = uni(s->kstepA);
    d.nM = uni(s->nM); d.nN = uni(s->nN); d.nM_ptr = unip(s->nM_ptr); d.amode = uni(s->amode); d.aidx = unip(s->aidx);
    d.bmode = uni(s->bmode); d.tile_e = unip(s->tile_e); d.bstride = (size_t)uni64((unsigned long long)s->bstride); d.epi = uni(s->epi);
    d.o0 = unip(s->o0); d.o1 = unip(s->o1); d.o2 = unip(s->o2); d.o3 = unip(s->o3); d.f0 = unip(s->f0); d.f1 = unip(s->f1);
    return d;
}
DEV int lds_byte(int r, int c) { const int st = (r >> 4) * 2 + (c >> 5), rr = r & 15, cc = c & 31, ob = rr * 64 + cc * 2; return st * 1024 + (ob ^ (((ob >> 9) & 1) << 5)); }
DEV void stage_rc(int b, int& R, int& C) { const int st = b / 1024, sb = b % 1024, swz = sb ^ (((sb >> 9) & 1) << 5); R = (st >> 1) * 16 + swz / 64; C = (st & 1) * 32 + (swz % 64) / 2; }

DEV float rope_pair(float v, float partner, bool hi, float cs, float sn) {
    return hi ? (v * cs + partner * sn) : (v * cs - partner * sn);
}

template <int EPI>
DEV void epi_quad(const Ctx& c, const GemmDesc& d, int row, int col, f32x4 v, int pm) {
    if (EPI == EPI_WOUT) {
        float* p = (float*)d.o0 + (size_t)row * DM + col;
        f32x4 x = *(f32x4*)p; x = x * DN_ALPHA + v; *(f32x4*)p = x;
    } else if (EPI == EPI_NSA_A) {
        const bool roped = (col < 1280) || (col >= 1536 && col < 2048);
        const int hd = col & 63;
        if (roped) {
            f32x4 pv; pv[0] = xor32_f(v[0], c.lane); pv[1] = xor32_f(v[1], c.lane); pv[2] = xor32_f(v[2], c.lane); pv[3] = xor32_f(v[3], c.lane);
            if (hd < 16) {
                const int pos = row & (SEQ - 1); const float* ct = c.w<float>(WS_ROPE) + pos * 8 + (hd & 7); const float* st = ct + 4096 * 8;
                const f32x4 cs = *(const f32x4*)ct, sn = *(const f32x4*)st; const bool hi = hd >= 8;
#pragma unroll
                for (int j = 0; j < 4; ++j) v[j] = rope_pair(v[j], pv[j], hi, cs[j], sn[j]);
            }
        }
        if (col < 1024) {
            v = v * QSCALE; u32x2 w; w.x = cvt_pk_bf16(v[0], v[1]); w.y = cvt_pk_bf16(v[2], v[3]);
            *(u32x2*)((bf16_t*)d.o0 + (size_t)row * 1024 + col) = w;
        } else if (col < 2048) {
            const int kb = (col - 1024) >> 8;
            u32x2 w; w.x = cvt_pk_bf16(v[0], v[1]); w.y = cvt_pk_bf16(v[2], v[3]);
            *(u32x2*)((bf16_t*)d.o1 + (size_t)kb * NTOK * 256 + (size_t)row * 256 + (col & 255)) = w;
        } else if (col < 2048 + 48) {
            f32x4 g; g[0] = sigmoidf_(v[0]); g[1] = sigmoidf_(v[1]); g[2] = sigmoidf_(v[2]); g[3] = sigmoidf_(v[3]);
            *(f32x4*)((float*)d.o2 + (size_t)row * 48 + (col - 2048)) = g;
        }
    } else if (EPI == EPI_NSA_V) {
        const int vb = row >> 8, kvh = (row >> 6) & 3, dd = row & 63, b = col >> 12, s = col & 4095;
        bf16_t* p = (bf16_t*)d.o0 + (size_t)vb * (8u * 4u * 64u * 4096u) + ((size_t)((b * 4 + kvh) * 64 + dd)) * 4096 + (s & ~15) + 8 * ((s >> 2) & 1) + 4 * ((s >> 3) & 1);
        u32x2 w; w.x = cvt_pk_bf16(v[0], v[1]); w.y = cvt_pk_bf16(v[2], v[3]); *(u32x2*)p = w;
    } else if (EPI == EPI_CMP1) {
        const int which = row >> 13; const f32x4 bb = *(const f32x4*)(d.f0 + which * 256 + col);
        v = v + bb; u32x2 w; w.x = cvt_pk_bf16(gelu_tanh(v[0]), gelu_tanh(v[1])); w.y = cvt_pk_bf16(gelu_tanh(v[2]), gelu_tanh(v[3]));
        *(u32x2*)((bf16_t*)d.o0 + (size_t)row * 256 + col) = w;
    } else if (EPI == EPI_GLA_A) {
        if (col < 1024) {
            u32x2 w; w.x = cvt_pk_bf16(v[0], v[1]); w.y = cvt_pk_bf16(v[2], v[3]);
            *(u32x2*)((bf16_t*)d.o0 + (size_t)(col >> 9) * NTOK * 512 + (size_t)row * 512 + (col & 511)) = w;
        } else if (col < 2048) {
            u32x2 w; w.x = cvt_pk_bf16(siluf_(v[0]), siluf_(v[1])); w.y = cvt_pk_bf16(siluf_(v[2]), siluf_(v[3]));
            *(u32x2*)((bf16_t*)d.o1 + (size_t)row * 1024 + (col - 1024)) = w;
        } else if (col < 2048 + 16) {
            *(f32x4*)((float*)d.o2 + (size_t)row * 16 + (col - 2048)) = v;
        }
    } else if (EPI == EPI_GLA_V) {
        const int b = col >> 12, s = col & 4095;
        u32x2 w; w.x = cvt_pk_bf16(v[0], v[1]); w.y = cvt_pk_bf16(v[2], v[3]);
        *(u32x2*)((bf16_t*)d.o0 + ((size_t)(b * 1024 + row)) * 4096 + s) = w;
    } else if (EPI == EPI_DIL_A) {
        const int hd = col & 63;
        f32x4 pv; pv[0] = xor32_f(v[0], c.lane); pv[1] = xor32_f(v[1], c.lane); pv[2] = xor32_f(v[2], c.lane); pv[3] = xor32_f(v[3], c.lane);
        if (hd < 16) {
            const int pos = row & (SEQ - 1); const float* ct = c.w<float>(WS_ROPE) + pos * 8 + (hd & 7); const float* st = ct + 4096 * 8;
            const f32x4 cs = *(const f32x4*)ct, sn = *(const f32x4*)st; const bool hi = hd >= 8;
#pragma unroll
            for (int j = 0; j < 4; ++j) v[j] = rope_pair(v[j], pv[j], hi, cs[j], sn[j]);
        }
        const int g = col >> 11, qk = (col >> 10) & 1;
        if (qk == 0) v = v * QSCALE;
        u32x2 w; w.x = cvt_pk_bf16(v[0], v[1]); w.y = cvt_pk_bf16(v[2], v[3]);
        *(u32x2*)((bf16_t*)(qk ? d.o1 : d.o0) + (size_t)g * NTOK * 1024 + (size_t)row * 1024 + (col & 1023)) = w;
    } else if (EPI == EPI_DIL_V) {
        const int g = row >> 10, hh = (row >> 6) & 15, dd = row & 63, b = col >> 12, jx = col & 4095;
        bf16_t* p = (bf16_t*)d.o0 + ((size_t)(((g * 8 + b) * 16 + hh) * 64 + dd)) * 4096 + (jx & ~15) + 8 * ((jx >> 2) & 1) + 4 * ((jx >> 3) & 1);
        u32x2 w; w.x = cvt_pk_bf16(v[0], v[1]); w.y = cvt_pk_bf16(v[2], v[3]); *(u32x2*)p = w;
    } else if (EPI == EPI_MOE2) {
        const int e = d.tile_e[pm];
        if (e == 64) {
            const int tok = ((const int*)d.o2)[row];
            float* p = (float*)d.o1 + (size_t)tok * DM + col;
            f32x4 x = *(f32x4*)p; x = x * DN_ALPHA + v; *(f32x4*)p = x;
        } else {
            const float gt = d.f0[row]; v = v * gt;
            u32x2 w; w.x = cvt_pk_bf16(v[0], v[1]); w.y = cvt_pk_bf16(v[2], v[3]);
            *(u32x2*)((bf16_t*)d.o0 + (size_t)row * 1024 + col) = w;
        }
    }
    (void)pm;
}


#define GSA(b, h) (((b) * 2 + (h)) * (HT * 2))
#define GSB(b, h) ((4 + (b) * 2 + (h)) * (HT * 2))
#define GLDS16(gp, lp) __builtin_amdgcn_global_load_lds((const unsigned*)(gp), (LAS unsigned*)(lp), 16, 0, 0)
#define STAGE(bufoff, g, voff) do { GLDS16((g) + (voff)[0], lds + (bufoff) + ldsw); GLDS16((g) + (voff)[1], lds + (bufoff) + ldsw + 8192); } while (0)
#define LDA(dst, b, h) _Pragma("unroll") for (int m = 0; m < 4; ++m) _Pragma("unroll") for (int k = 0; k < 2; ++k) \
    dst[m][k] = *(const LAS bf16x8*)(lds + GSA(b, h) + aoff + m * 2048 + k * 1024)
#define LDB(dst, b, h) _Pragma("unroll") for (int n = 0; n < 2; ++n) _Pragma("unroll") for (int k = 0; k < 2; ++k) \
    dst[n][k] = *(const LAS bf16x8*)(lds + GSB(b, h) + boff + n * 2048 + k * 1024)
#define MMA(ai, bj, At_, Bt_) do { __builtin_amdgcn_s_setprio(1); \
    _Pragma("unroll") for (int m = 0; m < 4; ++m) _Pragma("unroll") for (int n = 0; n < 2; ++n) _Pragma("unroll") for (int k = 0; k < 2; ++k) \
        acc[ai][bj][m][n] = __builtin_amdgcn_mfma_f32_16x16x32_bf16(Bt_[n][k], At_[m][k], acc[ai][bj][m][n], 0, 0, 0); \
    __builtin_amdgcn_s_setprio(0); } while (0)
#define WAIT_V(n) asm volatile("s_waitcnt vmcnt(" #n ")" ::: "memory")
#define WAIT_L(n) asm volatile("s_waitcnt lgkmcnt(" #n ")" ::: "memory")
#define BAR __builtin_amdgcn_s_barrier()
#define SCHED __builtin_amdgcn_sched_barrier(0)
#define EPI_LOOP(E) _Pragma("unroll") for (int ai = 0; ai < 2; ++ai) _Pragma("unroll") for (int bj = 0; bj < 2; ++bj) \
    _Pragma("unroll") for (int m = 0; m < 4; ++m) _Pragma("unroll") for (int n = 0; n < 2; ++n) \
        epi_quad<E>(c, d, brow + ai * HALF + wr * 64 + m * 16 + fr, bcol + bj * HALF + wc * 32 + n * 16 + fq * 4, acc[ai][bj][m][n], pm)

GEMM_LINKAGE void gemm_phase(int slot) {
    const Ctx c = make_ctx();
    const GemmDesc d = load_desc(c, slot);
    LAS unsigned char* lds = c.lds;
    const int nM = d.nM_ptr ? uni(*d.nM_ptr) : d.nM;
    const int nN = d.nN, U = nM * nN, nt = d.K / BK;
    const size_t kstA = (size_t)d.kstepA * 2, kstB = (size_t)BK * 2;
    for (int u = c.vcu; u < U; u += c.G) {
        const int pm = u / nN, pn = u - pm * nN, brow = pm * BM, bcol = pn * BM;
        int tz = threadIdx.x; asm volatile("" : "+v"(tz));
        const int wid = uni(tz >> 6), wr = wid >> 2, wc = wid & 3;
        const unsigned ldsw = (unsigned)wid * 1024u;
        const char* cA0; const char* cA1; const char* cB0; const char* cB1;
        unsigned voffA0[2], voffA1[2], voffB[2];
        {
            const char* Bb = (const char*)d.Bt;
            if (d.bmode == BM_EXP) Bb += (size_t)d.tile_e[pm] * d.bstride * 2;
            int sh = 0;
            if (d.bmode == BM_DIL) { sh = 2 * (pm >> 2); cB0 = Bb + (size_t)(bcol & ~4095) * d.ldb * 2; cB1 = cB0 + ((size_t)(128 << sh) * d.ldb) * 2; }
            else { cB0 = Bb + (size_t)bcol * d.ldb * 2; cB1 = cB0 + (size_t)HALF * d.ldb * 2; }
            if (d.amode == AM_CMP) { const int which = brow >> 13, bk = (brow & 8191) >> 8;
                cA0 = (const char*)d.A + ((size_t)which * (NTOK * 256) + (size_t)((bk >> 2) * SEQ) * 256 + (bk & 3) * 64) * 2; cA1 = cA0 + (size_t)HALF * d.lda * 2; }
            else if (d.amode == AM_IDX) { cA0 = (const char*)d.A; cA1 = cA0; }
            else { cA0 = (const char*)d.A + (size_t)brow * d.lda * 2; cA1 = cA0 + (size_t)HALF * d.lda * 2; }
#pragma unroll
            for (int i = 0; i < 2; ++i) {
                int R, C; stage_rc(tz * 16 + i * 8192, R, C);
                if (d.amode == AM_IDX) { voffA0[i] = (unsigned)(d.aidx[brow + R] * d.lda + C) * 2u; voffA1[i] = (unsigned)(d.aidx[brow + HALF + R] * d.lda + C) * 2u; }
                else { voffA0[i] = (unsigned)(R * d.lda + C) * 2u; voffA1[i] = voffA0[i]; }
                if (d.bmode == BM_DIL) { const int jx = (bcol & 4095) + R, rr = jx >> (12 - sh), uu = jx & ((4096 >> sh) - 1); voffB[i] = (unsigned)(((uu << sh) | rr) * d.ldb + C) * 2u; }
                else voffB[i] = (unsigned)(R * d.ldb + C) * 2u;
            }
        }
        asm volatile("s_waitcnt vmcnt(0)" ::: "memory");
        f32x4 acc[2][2][4][2];
#pragma unroll
        for (int ai = 0; ai < 2; ++ai)
#pragma unroll
            for (int bj = 0; bj < 2; ++bj)
#pragma unroll
                for (int m = 0; m < 4; ++m)
#pragma unroll
                    for (int n = 0; n < 2; ++n) acc[ai][bj][m][n] = (f32x4){0.f, 0.f, 0.f, 0.f};
        bf16x8 At[4][2], B0[2][2], B1[2][2];
        {
        const int lane = tz & 63, fr = lane & 15, fq = lane >> 4;
        const int aoff = lds_byte(wr * 64 + fr, fq * 8), boff = lds_byte(wc * 32 + fr, fq * 8);
        STAGE(GSB(0, 0), cB0, voffB); STAGE(GSA(0, 0), cA0, voffA0);
        STAGE(GSB(0, 1), cB1, voffB); STAGE(GSA(0, 1), cA1, voffA1);
        if (wr == 1) BAR;
        WAIT_V(4); BAR;
        STAGE(GSB(1, 0), cB0 + kstB, voffB); STAGE(GSA(1, 0), cA0 + kstA, voffA0); STAGE(GSB(1, 1), cB1 + kstB, voffB);
        WAIT_V(6); BAR;
        for (int t = 0; t < nt - 2; t += 2) {
            const char* a1 = cA1 + (size_t)(t + 1) * kstA;
            const char* a20 = cA0 + (size_t)(t + 2) * kstA; const char* a21 = cA1 + (size_t)(t + 2) * kstA;
            const char* b20 = cB0 + (size_t)(t + 2) * kstB; const char* b21 = cB1 + (size_t)(t + 2) * kstB;
            LDB(B0, 0, 0); SCHED; LDA(At, 0, 0); STAGE(GSA(1, 1), a1, voffA1);
            WAIT_L(8); BAR; WAIT_L(0); MMA(0, 0, At, B0); BAR; SCHED;
            LDB(B1, 0, 1); STAGE(GSB(0, 0), b20, voffB);
            BAR; WAIT_L(0); MMA(0, 1, At, B1); BAR;
            LDA(At, 0, 1); STAGE(GSA(0, 0), a20, voffA0);
            BAR; WAIT_L(0); MMA(1, 0, At, B0); BAR; SCHED;
            STAGE(GSB(0, 1), b21, voffB);
            WAIT_V(6); BAR; MMA(1, 1, At, B1); BAR;
            LDB(B0, 1, 0); SCHED; LDA(At, 1, 0); STAGE(GSA(0, 1), a21, voffA1);
            WAIT_L(8); BAR; WAIT_L(0); MMA(0, 0, At, B0); BAR; SCHED;
            LDB(B1, 1, 1); STAGE(GSB(1, 0), b20 + kstB, voffB);
            BAR; WAIT_L(0); MMA(0, 1, At, B1); BAR;
            LDA(At, 1, 1); STAGE(GSA(1, 0), a20 + kstA, voffA0);
            BAR; WAIT_L(0); MMA(1, 0, At, B0); BAR; SCHED;
            STAGE(GSB(1, 1), b21 + kstB, voffB);
            WAIT_V(6); BAR; MMA(1, 1, At, B1); BAR;
        }
        { LDB(B0, 0, 0); WAIT_V(0); LDA(At, 0, 0); STAGE(GSA(1, 1), cA1 + (size_t)(nt - 1) * kstA, voffA1);
          BAR; WAIT_L(0); MMA(0, 0, At, B0); BAR;
          LDB(B1, 0, 1); BAR; WAIT_L(0); MMA(0, 1, At, B1); BAR;
          LDA(At, 0, 1); WAIT_V(4); BAR; WAIT_L(0); MMA(1, 0, At, B0); MMA(1, 1, At, B1); BAR; }
        { LDB(B0, 1, 0); LDA(At, 1, 0); WAIT_V(2); BAR; WAIT_L(0); MMA(0, 0, At, B0); BAR;
          LDB(B1, 1, 1); WAIT_V(0); BAR; WAIT_L(0); MMA(0, 1, At, B1); BAR;
          LDA(At, 1, 1); BAR; WAIT_L(0); MMA(1, 0, At, B0); MMA(1, 1, At, B1); BAR; }
        if (wr == 0) BAR;
        }
        int ty = threadIdx.x; asm volatile("" : "+v"(ty));
        const int lane = ty & 63, fr = lane & 15, fq = lane >> 4;
        switch (d.epi) {
        case EPI_WOUT:  EPI_LOOP(EPI_WOUT); break;
        case EPI_NSA_A: EPI_LOOP(EPI_NSA_A); break;
        case EPI_NSA_V: EPI_LOOP(EPI_NSA_V); break;
        case EPI_CMP1:  EPI_LOOP(EPI_CMP1); break;
        case EPI_GLA_A: EPI_LOOP(EPI_GLA_A); break;
        case EPI_GLA_V: EPI_LOOP(EPI_GLA_V); break;
        case EPI_DIL_A: EPI_LOOP(EPI_DIL_A); break;
        case EPI_DIL_V: EPI_LOOP(EPI_DIL_V); break;
        case EPI_MOE2:  EPI_LOOP(EPI_MOE2); break;
        case EPI_MOE1: {
#pragma unroll
            for (int ai = 0; ai < 2; ++ai)
#pragma unroll
                for (int m = 0; m < 4; ++m)
#pragma unroll
                    for (int n = 0; n < 2; ++n) {
                        const f32x4 g = acc[ai][0][m][n], uu = acc[ai][1][m][n];
                        u32x2 w; w.x = cvt_pk_bf16(siluf_(g[0]) * uu[0], siluf_(g[1]) * uu[1]); w.y = cvt_pk_bf16(siluf_(g[2]) * uu[2], siluf_(g[3]) * uu[3]);
                        const int row = brow + ai * HALF + wr * 64 + m * 16 + fr, colh = pn * 128 + wc * 32 + n * 16 + fq * 4;
                        *(u32x2*)((bf16_t*)d.o0 + (size_t)row * 256 + colh) = w;
                    }
        } break;
        default: break;
        }
        asm volatile("s_waitcnt vmcnt(0)" ::: "memory");
        __syncthreads();
    }
}

__device__ void route_a(const float* rb) {
    const Ctx c = make_ctx();
    const bf16_t* xb = c.w<bf16_t>(WS_XB);
    const bf16_t* rwt = c.w<bf16_t>(WS_WR);
    int* PE = c.w<int>(A_PE); float* PG = c.w<float>(A_PG); int* PR = c.w<int>(A_PR);
    int* CNT = c.w<int>(WS_META) + META_CNT;
    LAS int* el = (LAS int*)c.lds;
    LAS int* lr = el + 1024;
    const int fr = c.lane & 15, fq = c.lane >> 4;
    for (int unit = c.vcu; unit < NTOK / 128; unit += c.G) {
        const int tok0 = unit * 128 + c.wave * 16;
        f32x4 acc[4];
#pragma unroll
        for (int nt = 0; nt < 4; ++nt) acc[nt] = (f32x4){0.f, 0.f, 0.f, 0.f};
        const bf16_t* xr = xb + (size_t)(tok0 + fr) * DM + fq * 8;
        const bf16_t* wr_ = rwt + (size_t)fr * DM + fq * 8;
#pragma unroll 4
        for (int ks = 0; ks < 32; ++ks) {
            const bf16x8 bx = *(const bf16x8*)(xr + ks * 32);
#pragma unroll
            for (int nt = 0; nt < 4; ++nt) {
                const bf16x8 aw = *(const bf16x8*)(wr_ + (size_t)nt * 16 * DM + ks * 32);
                acc[nt] = __builtin_amdgcn_mfma_f32_16x16x32_bf16(aw, bx, acc[nt], 0, 0, 0);
            }
        }
        float s[16], sb[16];
#pragma unroll
        for (int q = 0; q < 16; ++q) { s[q] = sigmoidf_(acc[q >> 2][q & 3]); sb[q] = s[q] + rb[16 * fq + q]; }
        float gs[2];
#pragma unroll
        for (int hh = 0; hh < 2; ++hh) {
            float m1 = -3.0e38f, m2 = -3.0e38f;
#pragma unroll
            for (int q = 0; q < 8; ++q) { const float v = sb[8 * hh + q]; const bool gt = v > m1; m2 = gt ? m1 : fmaxf(m2, v); m1 = gt ? v : m1; }
            gs[hh] = m1 + m2;
        }
        float ga[8];
#pragma unroll
        for (int f2 = 0; f2 < 4; ++f2) { ga[2 * f2] = bperm_f(fr + 16 * f2, gs[0]); ga[2 * f2 + 1] = bperm_f(fr + 16 * f2, gs[1]); }
        bool gsel[2];
#pragma unroll
        for (int hh = 0; hh < 2; ++hh) {
            const int gi = 2 * fq + hh; const float mine = gs[hh]; int cnt = 0;
#pragma unroll
            for (int gj = 0; gj < 8; ++gj) cnt += (ga[gj] > mine || (ga[gj] == mine && gj < gi)) ? 1 : 0;
            gsel[hh] = cnt < 4;
        }
        float val[16];
#pragma unroll
        for (int q = 0; q < 16; ++q) val[q] = gsel[q >> 3] ? sb[q] : -3.0e38f;
        int ek[8]; float sk[8]; float ssum = 0.f;
#pragma unroll
        for (int k = 0; k < 8; ++k) {
            float bv = val[0], bs = s[0]; int bq = 0;
#pragma unroll
            for (int q = 1; q < 16; ++q) { const bool gt = val[q] > bv; bv = gt ? val[q] : bv; bs = gt ? s[q] : bs; bq = gt ? q : bq; }
            int be = 16 * fq + bq;
#pragma unroll
            for (int o = 16; o <= 32; o <<= 1) {
                const float ov = bperm_f(c.lane ^ o, bv), os = bperm_f(c.lane ^ o, bs); const int oe = bperm_i(c.lane ^ o, be);
                const bool take = (ov > bv) || (ov == bv && oe < be);
                bv = take ? ov : bv; bs = take ? os : bs; be = take ? oe : be;
            }
            ek[k] = be; sk[k] = bs; ssum += bs;
            const bool mine = (be >> 4) == fq; const int mq = be & 15;
#pragma unroll
            for (int q = 0; q < 16; ++q) val[q] = (mine && q == mq) ? -3.3e38f : val[q];
        }
        const float gsc = 2.5f / ssum;
        if (fq == 0) {
            const int tl = c.wave * 16 + fr, tg = tok0 + fr;
#pragma unroll
            for (int k = 0; k < 8; ++k) { el[tl * 8 + k] = ek[k]; PE[tg * 8 + k] = ek[k]; PG[tg * 8 + k] = sk[k] * gsc; }
        }
        __syncthreads();
        if (c.tid < 64) {
            int cnt = 0;
            for (int p = 0; p < 1024; ++p) { if (el[p] == c.tid) { lr[p] = cnt; ++cnt; } }
            CNT[unit * 64 + c.tid] = cnt;
        }
        __syncthreads();
        PR[unit * 1024 + c.tid] = lr[c.tid]; PR[unit * 1024 + 512 + c.tid] = lr[512 + c.tid];
        __syncthreads();
    }
}

__device__ void route_b() {
    const Ctx c = make_ctx();
    const int* PE = c.w<int>(A_PE); const float* PG = c.w<float>(A_PG); const int* PR = c.w<int>(A_PR);
    int* POS = c.w<int>(A_POS); int* ROWTOK = c.w<int>(A_ROWTOK); float* ROWGATE = c.w<float>(A_ROWGATE);
    int* meta = c.w<int>(WS_META); const int* CNT = meta + META_CNT;
    LAS int* tot = (LAS int*)c.lds; LAS int* bef = tot + 64; LAS int* seg = bef + 64;
    const int nunit = NTOK / 128;
    for (int unit = c.vcu; unit < nunit; unit += c.G) {
        if (c.tid < 64) {
            int t = 0, b = 0;
            for (int u2 = 0; u2 < nunit; ++u2) { const int v = CNT[u2 * 64 + c.tid]; b += (u2 < unit) ? v : 0; t += v; }
            tot[c.tid] = t; bef[c.tid] = b;
        }
        __syncthreads();
        if (c.tid == 0) { int sg = 0; for (int e = 0; e < 64; ++e) { seg[e] = sg; sg += (tot[e] + 255) & ~255; } seg[64] = sg; }
        __syncthreads();
        const int P0 = seg[64];
        for (int p = c.tid; p < 1024; p += NTHR) {
            const int tok = unit * 128 + (p >> 3), gi = tok * 8 + (p & 7);
            const int e = PE[gi], dest = seg[e] + bef[e] + PR[unit * 1024 + p];
            POS[gi] = dest; ROWTOK[dest] = tok; ROWGATE[dest] = PG[gi];
        }
        if (unit < 64) {
            const int e = unit, lo = seg[e] + tot[e], hi = seg[e + 1];
            for (int r = lo + c.tid; r < hi; r += NTHR) { ROWTOK[r] = NTOK; ROWGATE[r] = 0.f; }
        }
        if (c.tid < 128) { const int r = P0 + unit * 128 + c.tid; ROWTOK[r] = unit * 128 + c.tid; ROWGATE[r] = 1.f; }
        if (unit == 0) {
            if (c.tid < 64) { for (int mt = seg[c.tid] >> 8; mt < (seg[c.tid + 1] >> 8); ++mt) meta[META_TILE + mt] = c.tid; }
            if (c.tid < 128) meta[META_TILE + (P0 >> 8) + c.tid] = 64;
            if (c.tid == 0) meta[META_NMT] = (P0 >> 8) + NTOK / 256;
        }
        __syncthreads();
    }
}

#define NEG_INF_F (-__builtin_inff())
struct FlashState { f32x16 o0, o1; float m, l; };
DEV void flash_init(FlashState& st) {
#pragma unroll
    for (int i = 0; i < 16; ++i) { st.o0[i] = 0.f; st.o1[i] = 0.f; }
    st.m = NEG_INF_F; st.l = 0.f;
}
DEV bf16x8 pack8(const f32x16& p, int base) {
    u32x4 w; w.x = cvt_pk_bf16(p[base + 0], p[base + 1]); w.y = cvt_pk_bf16(p[base + 2], p[base + 3]);
    w.z = cvt_pk_bf16(p[base + 4], p[base + 5]); w.w = cvt_pk_bf16(p[base + 6], p[base + 7]);
    return __builtin_bit_cast(bf16x8, w);
}
DEV f32x16 qk_tile(const bf16x8 (&kf)[4], const bf16x8 (&qf)[4]) {
    f32x16 S;
#pragma unroll
    for (int i = 0; i < 16; ++i) S[i] = 0.f;
#pragma unroll
    for (int s = 0; s < 4; ++s) S = __builtin_amdgcn_mfma_f32_32x32x16_bf16(kf[s], qf[s], S, 0, 0, 0);
    return S;
}
DEV void flash_tile(FlashState& st, f32x16 S, const bf16x8 (&vf)[4], bool need_mask, unsigned vmask, int lane) {
    if (need_mask) {
#pragma unroll
        for (int i = 0; i < 16; ++i) S[i] = ((vmask >> i) & 1u) ? S[i] : NEG_INF_F;
    }
    float mx = S[0];
#pragma unroll
    for (int i = 1; i < 16; ++i) mx = fmaxf(mx, S[i]);
    mx = fmaxf(mx, xor32_f(mx, lane));
    const float mn = fmaxf(st.m, mx);
    const float mu = (mn == NEG_INF_F) ? 0.f : mn;
    const float alpha = fast_exp2(st.m - mu);
    float ls = 0.f;
#pragma unroll
    for (int i = 0; i < 16; ++i) { S[i] = fast_exp2(S[i] - mu); ls += S[i]; }
    st.l = st.l * alpha + ls; st.m = mn;
    if (__builtin_amdgcn_ballot_w64(alpha != 1.f) != 0ull) {
#pragma unroll
        for (int i = 0; i < 16; ++i) { st.o0[i] *= alpha; st.o1[i] *= alpha; }
    }
    const bf16x8 p0 = pack8(S, 0), p1 = pack8(S, 8);
    st.o0 = __builtin_amdgcn_mfma_f32_32x32x16_bf16(vf[0], p0, st.o0, 0, 0, 0);
    st.o0 = __builtin_amdgcn_mfma_f32_32x32x16_bf16(vf[1], p1, st.o0, 0, 0, 0);
    st.o1 = __builtin_amdgcn_mfma_f32_32x32x16_bf16(vf[2], p0, st.o1, 0, 0, 0);
    st.o1 = __builtin_amdgcn_mfma_f32_32x32x16_bf16(vf[3], p1, st.o1, 0, 0, 0);
}
DEV int key_of(int key0, int i, int h) { return key0 + (i & 3) + 8 * (i >> 2) + 4 * h; }

template <class P>
DEV void flash_load(const P& pol, int tile, int r, int h, bf16x8 (&kf)[4], bf16x8 (&vf)[4]) {
    const bf16_t* kp = pol.kptr(tile * 32 + r) + 8 * h;
#pragma unroll
    for (int s = 0; s < 4; ++s) kf[s] = *(const bf16x8*)(kp + 16 * s);
    const bf16_t* v0 = pol.vptr(r) + tile * 32 + 8 * h;
    const bf16_t* v1 = pol.vptr(32 + r) + tile * 32 + 8 * h;
    vf[0] = *(const bf16x8*)(v0); vf[1] = *(const bf16x8*)(v0 + 16); vf[2] = *(const bf16x8*)(v1); vf[3] = *(const bf16x8*)(v1 + 16);
}
template <class P>
DEV void flash_run(const P& pol, const bf16x8 (&qf)[4], FlashState& st, int t0, int t1, int r, int h) {
    int t = t0;
    while (t < t1 && pol.skip(t)) ++t;
    if (t >= t1) return;
    bf16x8 kc[4], vc[4], kn[4], vn[4];
    flash_load(pol, t, r, h, kc, vc);
    while (t < t1) {
        int tn = t + 1;
        while (tn < t1 && pol.skip(tn)) ++tn;
        if (tn < t1) flash_load(pol, tn, r, h, kn, vn);
        const f32x16 S = qk_tile(kc, qf);
        const bool nm = pol.need_mask(t);
        flash_tile(st, S, vc, nm, nm ? pol.vmask(t * 32) : 0u, 32 * h + r);
#pragma unroll
        for (int s = 0; s < 4; ++s) { kc[s] = kn[s]; vc[s] = vn[s]; }
        t = tn;
    }
}
template <bool FIRST>
DEV void flash_accum(const FlashState& st, float gate, LAS float* ot, int lane) {
    const float lt = st.l + xor32_f(st.l, lane);
    const float sc = lt > 0.f ? gate * fast_rcp(lt) : 0.f;
#pragma unroll
    for (int i = 0; i < 16; ++i) {
        if (FIRST) { ot[i * 64 + lane] = st.o0[i] * sc; ot[(16 + i) * 64 + lane] = st.o1[i] * sc; }
        else { ot[i * 64 + lane] += st.o0[i] * sc; ot[(16 + i) * 64 + lane] += st.o1[i] * sc; }
    }
}
DEV void store_o(bf16_t* dst, const f32x16& t0, const f32x16& t1, int h) {
#pragma unroll
    for (int a = 0; a < 4; ++a) {
        u32x2 w; w.x = cvt_pk_bf16(t0[4 * a], t0[4 * a + 1]); w.y = cvt_pk_bf16(t0[4 * a + 2], t0[4 * a + 3]);
        *(u32x2*)(dst + 8 * a + 4 * h) = w;
        u32x2 x; x.x = cvt_pk_bf16(t1[4 * a], t1[4 * a + 1]); x.y = cvt_pk_bf16(t1[4 * a + 2], t1[4 * a + 3]);
        *(u32x2*)(dst + 32 + 8 * a + 4 * h) = x;
    }
}

struct PolCmp {
    const bf16_t* kb; const bf16_t* vb; int t, t0, h;
    DEV const bf16_t* kptr(int key) const { return kb + (size_t)min(key, 255) * 64; }
    DEV const bf16_t* vptr(int d) const { return vb + (size_t)d * 256; }
    DEV bool skip(int) const { return false; }
    DEV bool need_mask(int tile) const { return 16 * (tile * 32 + 31) + 31 > t0; }
    DEV unsigned vmask(int key0) const { unsigned m = 0;
#pragma unroll
        for (int i = 0; i < 16; ++i) m |= (16 * key_of(key0, i, h) + 31 <= t) ? (1u << i) : 0u;
        return m; }
};
struct PolSel {
    const bf16_t* kb; const bf16_t* vb; int t, t0, h; unsigned mlo, mhi;
    DEV bool selb(int tile) const { const int blk = tile >> 1; return ((blk < 32 ? (mlo >> blk) : (mhi >> (blk - 32))) & 1u) != 0u; }
    DEV const bf16_t* kptr(int key) const { return kb + (size_t)key * 256; }
    DEV const bf16_t* vptr(int d) const { return vb + (size_t)d * 4096; }
    DEV bool skip(int tile) const { return __builtin_amdgcn_ballot_w64(selb(tile)) == 0ull; }
    DEV bool need_mask(int tile) const { return (tile * 32 + 31 > t0) || (__builtin_amdgcn_ballot_w64(!selb(tile)) != 0ull); }
    DEV unsigned vmask(int key0) const { if (!selb(key0 >> 5)) return 0u; unsigned m = 0;
#pragma unroll
        for (int i = 0; i < 16; ++i) m |= (key_of(key0, i, h) <= t) ? (1u << i) : 0u;
        return m; }
};
struct PolWin {
    const bf16_t* kb; const bf16_t* vb; int t, t0, h;
    DEV const bf16_t* kptr(int key) const { return kb + (size_t)key * 256; }
    DEV const bf16_t* vptr(int d) const { return vb + (size_t)d * 4096; }
    DEV bool skip(int) const { return false; }
    DEV bool need_mask(int tile) const { return (tile * 32 + 31 > t0) || (tile * 32 < t0 + 7 - 511); }
    DEV unsigned vmask(int key0) const { unsigned m = 0;
#pragma unroll
        for (int i = 0; i < 16; ++i) { const int dd = t - key_of(key0, i, h); m |= (dd >= 0 && dd < 512) ? (1u << i) : 0u; }
        return m; }
};

__device__ void nsa_unit(const Ctx& c, int b, int kvh, int p, LAS float* lds_w) {
    const int r = c.lane & 31, h = c.lane >> 5, ql = r >> 2, g = r & 3;
    const int t0 = p * 8, t = t0 + ql, head = kvh * 4 + g, gtok = b * SEQ + t, bk = b * 4 + kvh;
    const bf16_t* Q = c.w<bf16_t>(N_Q);
    bf16x8 qf[4];
#pragma unroll
    for (int s = 0; s < 4; ++s) qf[s] = *(const bf16x8*)(Q + (size_t)gtok * 1024 + head * 64 + 16 * s + 8 * h);
    const float* gt = c.w<float>(N_GATE) + (size_t)gtok * 48 + head * 3;
    const float g0 = gt[0], g1 = gt[1], g2 = gt[2];
    LAS float* ot = lds_w + 1024;
    const int cur = p >> 3;
    unsigned mlo, mhi;
    {
        PolCmp pc; pc.kb = c.w<bf16_t>(N_KCMP) + (size_t)bk * 256 * 64; pc.vb = c.w<bf16_t>(N_VCMPT) + (size_t)bk * 64 * 256; pc.t = t; pc.t0 = t0; pc.h = h;
        const int tmax = t0 + 7, ncmp = tmax >= 31 ? ((tmax - 31) >> 4) + 1 : 0, ntc = (ncmp + 31) >> 5;
        FlashState sc; flash_init(sc);
        flash_run(pc, qf, sc, 0, ntc, r, h);
        flash_accum<true>(sc, g0, ot, c.lane);
        if (cur < 16) { const unsigned long long mm = (cur + 1 >= 64) ? ~0ull : ((1ull << (cur + 1)) - 1ull); mlo = (unsigned)mm; mhi = (unsigned)(mm >> 32); }
        else {
            LAS float* GL = lds_w; LAS float* LL = lds_w + 512;
#pragma unroll
            for (int i = 0; i < 16; ++i) lds_w[c.lane + 64 * i] = 0.f;
            __builtin_amdgcn_wave_barrier();
            const float lt = sc.l + xor32_f(sc.l, c.lane);
            const float il = lt > 0.f ? fast_rcp(lt) : 0.f;
            const float mu = (sc.m == NEG_INF_F) ? 0.f : sc.m;
#pragma nounroll
            for (int T = 0; T < ntc; ++T) {
                bf16x8 kf[4];
                const bf16_t* kp = pc.kptr(T * 32 + r) + 8 * h;
#pragma unroll
                for (int s = 0; s < 4; ++s) kf[s] = *(const bf16x8*)(kp + 16 * s);
                f32x16 S = qk_tile(kf, qf);
                const unsigned vm = pc.vmask(T * 32);
#pragma unroll
                for (int i = 0; i < 16; ++i) S[i] = ((vm >> i) & 1u) ? fast_exp2(S[i] - mu) * il : 0.f;
#pragma unroll
                for (int k = 0; k < 4; ++k) {
                    float gs = (S[4 * k] + S[4 * k + 1]) + (S[4 * k + 2] + S[4 * k + 3]), ls = S[4 * k + 3];
                    gs += swz_xor<1>(gs); gs += swz_xor<2>(gs); ls += swz_xor<1>(ls); ls += swz_xor<2>(ls);
                    const int n = 8 * T + 2 * k + h;
                    if (g == 0) { GL[ql * 64 + n] = gs; LL[ql * 64 + n] = ls; }
                }
            }
            __builtin_amdgcn_wave_barrier();
            asm volatile("s_waitcnt lgkmcnt(0)" ::: "memory");
            const int qs = c.lane >> 3, part = c.lane & 7;
            float mine[8]; int cnt[8];
#pragma unroll
            for (int j = 0; j < 8; ++j) { const int n = part * 8 + j; mine[j] = GL[qs * 64 + n] + (n > 0 ? LL[qs * 64 + n - 1] : 0.f); cnt[j] = 0; }
#pragma nounroll
            for (int m = 1; m <= cur - 2; ++m) {
                const float vm = GL[qs * 64 + m] + LL[qs * 64 + m - 1];
#pragma unroll
                for (int j = 0; j < 8; ++j) { const int n = part * 8 + j; cnt[j] += (vm > mine[j] || (vm == mine[j] && m < n)) ? 1 : 0; }
            }
            unsigned byte = 0;
#pragma unroll
            for (int j = 0; j < 8; ++j) { const int n = part * 8 + j;
                const bool sel = (n == 0) || (n == cur) || (n == cur - 1) || (n >= 1 && n <= cur - 2 && cnt[j] < 13);
                byte |= sel ? (1u << j) : 0u; }
            unsigned lo = 0, hi = 0;
#pragma unroll
            for (int pp = 0; pp < 4; ++pp) { lo |= (unsigned)bperm_i(qs * 8 + pp, (int)byte) << (8 * pp); hi |= (unsigned)bperm_i(qs * 8 + 4 + pp, (int)byte) << (8 * pp); }
            mlo = (unsigned)bperm_i(ql * 8, (int)lo); mhi = (unsigned)bperm_i(ql * 8, (int)hi);
            __builtin_amdgcn_wave_barrier();
        }
    }
    {
        PolSel ps; ps.kb = c.w<bf16_t>(N_KS) + (size_t)b * SEQ * 256 + kvh * 64; ps.vb = c.w<bf16_t>(N_VTS) + (size_t)bk * 64 * 4096; ps.t = t; ps.t0 = t0; ps.h = h; ps.mlo = mlo; ps.mhi = mhi;
        FlashState ss; flash_init(ss);
        flash_run(ps, qf, ss, 0, ((t0 + 7) >> 5) + 1, r, h);
        flash_accum<false>(ss, g1, ot, c.lane);
    }
    {
        PolWin pw; pw.kb = c.w<bf16_t>(N_KW) + (size_t)b * SEQ * 256 + kvh * 64; pw.vb = c.w<bf16_t>(N_VTW) + (size_t)bk * 64 * 4096; pw.t = t; pw.t0 = t0; pw.h = h;
        FlashState sw; flash_init(sw);
        const int lo = t0 - 511;
        flash_run(pw, qf, sw, (lo > 0 ? lo : 0) >> 5, ((t0 + 7) >> 5) + 1, r, h);
        flash_accum<false>(sw, g2, ot, c.lane);
    }
    f32x16 ot0, ot1;
#pragma unroll
    for (int i = 0; i < 16; ++i) { ot0[i] = ot[i * 64 + c.lane]; ot1[i] = ot[(16 + i) * 64 + c.lane]; }
    store_o(c.w<bf16_t>(N_O) + (size_t)gtok * 1024 + head * 64, ot0, ot1, h);
}

__device__ void nsa_attn_phase() {
    const Ctx c = make_ctx();
    LAS float* lds_w = (LAS float*)(c.lds + c.wave * 12288);
    const int NW = c.G * NWAVE, wg = c.vcu * NWAVE + c.wave;
    for (int I = wg; I < 32 * 512; I += NW) {
        int bk, p;
        if (NW == 2048) { const int x = wg >> 8, wl = wg & 255, j = I >> 11, I2 = j * 256 + wl; bk = 4 * x + (I2 & 3); p = I2 >> 2; }
        else { bk = I & 31; p = I >> 5; }
        nsa_unit(c, bk >> 2, bk & 3, p, lds_w);
    }
}

__device__ void nsa_cmp2_phase() {
    const Ctx c = make_ctx();
    const bf16_t* HC = c.w<bf16_t>(N_HC); const bf16_t* W2 = c.w<bf16_t>(WS_WMIX) + NW_W2;
    bf16_t* KC = c.w<bf16_t>(N_KCMP); bf16_t* VT = c.w<bf16_t>(N_VCMPT);
    const int r = c.lane & 31, h = c.lane >> 5, NW = c.G * NWAVE, wg = c.vcu * NWAVE + c.wave;
    for (int u = wg; u < 512; u += NW) {
        const int row0 = u * 32, which = row0 >> 13;
        const bf16_t* w2 = W2 + (size_t)which * 64 * 256;
        f32x16 a0, a1;
#pragma unroll
        for (int i = 0; i < 16; ++i) { a0[i] = 0.f; a1[i] = 0.f; }
        const bf16_t* ap = HC + (size_t)(row0 + r) * 256 + 8 * h;
#pragma unroll 4
        for (int ks = 0; ks < 16; ++ks) {
            const bf16x8 af = *(const bf16x8*)(ap + ks * 16);
            const bf16x8 b0 = *(const bf16x8*)(w2 + (size_t)r * 256 + ks * 16 + 8 * h);
            const bf16x8 b1 = *(const bf16x8*)(w2 + (size_t)(32 + r) * 256 + ks * 16 + 8 * h);
            a0 = __builtin_amdgcn_mfma_f32_32x32x16_bf16(af, b0, a0, 0, 0, 0);
            a1 = __builtin_amdgcn_mfma_f32_32x32x16_bf16(af, b1, a1, 0, 0, 0);
        }
        const int R = row0 & 8191, bkk = R >> 8, c0 = R & 255;
        if (which == 0) {
#pragma unroll
            for (int i = 0; i < 16; ++i) { const int cc = c0 + (i & 3) + 8 * (i >> 2) + 4 * h;
                KC[((size_t)bkk * 256 + cc) * 64 + r] = f2bf(a0[i]); KC[((size_t)bkk * 256 + cc) * 64 + 32 + r] = f2bf(a1[i]); }
        } else {
#pragma unroll
            for (int a = 0; a < 4; ++a) { const int cc = c0 + 8 * a + 4 * h;
                const int pos = (cc & ~15) + 8 * ((cc >> 2) & 1) + 4 * ((cc >> 3) & 1);
                u32x2 w; w.x = cvt_pk_bf16(a0[4 * a], a0[4 * a + 1]); w.y = cvt_pk_bf16(a0[4 * a + 2], a0[4 * a + 3]);
                *(u32x2*)(VT + ((size_t)bkk * 64 + r) * 256 + pos) = w;
                u32x2 x; x.x = cvt_pk_bf16(a1[4 * a], a1[4 * a + 1]); x.y = cvt_pk_bf16(a1[4 * a + 2], a1[4 * a + 3]);
                *(u32x2*)(VT + ((size_t)bkk * 64 + 32 + r) * 256 + pos) = x; }
        }
    }
}

struct PolDil {
    const bf16_t* kb; const bf16_t* vb; int u, u0, h, kstride;
    DEV const bf16_t* kptr(int key) const { return kb + (size_t)key * kstride; }
    DEV const bf16_t* vptr(int d) const { return vb + (size_t)d * 4096; }
    DEV bool skip(int) const { return false; }
    DEV bool need_mask(int tile) const { return (tile * 32 + 31 > u0) || (tile * 32 < u0 + 31 - 128); }
    DEV unsigned vmask(int key0) const { unsigned m = 0;
#pragma unroll
        for (int i = 0; i < 16; ++i) { const int dd = u - key_of(key0, i, h); m |= (dd >= 0 && dd <= 128) ? (1u << i) : 0u; }
        return m; }
};
__device__ void dil_attn_phase() {
    const Ctx c = make_ctx();
    const int r = c.lane & 31, h = c.lane >> 5, NW = c.G * NWAVE, wg = c.vcu * NWAVE + c.wave;
    for (int I = wg; I < 3 * 16384; I += NW) {
        const int g = I >> 14, J = I & 16383, bh = J >> 7, W = J & 127, b = bh >> 4, head = bh & 15;
        const int sh = 2 * g, L = SEQ >> sh, nub = L >> 5;
        const int rc = W / nub, ublk = W - rc * nub;
        const int u0 = ublk * 32, u = u0 + r, tok = b * SEQ + (u << sh) + rc;
        const bf16_t* Qd = c.w<bf16_t>(D_Q) + (size_t)g * NTOK * 1024;
        bf16x8 qf[4];
#pragma unroll
        for (int s = 0; s < 4; ++s) qf[s] = *(const bf16x8*)(Qd + (size_t)tok * 1024 + head * 64 + 16 * s + 8 * h);
        PolDil pd; pd.kb = c.w<bf16_t>(D_K) + (size_t)g * NTOK * 1024 + ((size_t)b * SEQ + rc) * 1024 + head * 64; pd.kstride = 1024 << sh;
        pd.vb = c.w<bf16_t>(D_VT) + ((size_t)((g * 8 + b) * 16 + head) * 64) * 4096 + rc * L; pd.u = u; pd.u0 = u0; pd.h = h;
        FlashState st; flash_init(st);
        flash_run(pd, qf, st, (ublk > 4 ? ublk - 4 : 0), ublk + 1, r, h);
        const float lt = st.l + xor32_f(st.l, c.lane);
        const float sc = fast_rcp(lt);
        f32x16 o0, o1;
#pragma unroll
        for (int i = 0; i < 16; ++i) { o0[i] = st.o0[i] * sc; o1[i] = st.o1[i] * sc; }
        store_o(c.w<bf16_t>(D_OG) + (size_t)g * NTOK * 1024 + (size_t)tok * 1024 + head * 64, o0, o1, h);
        if (h == 0) c.w<float>(D_LSE)[(size_t)g * NTOK * 16 + (size_t)tok * 16 + head] = st.m + __log2f(lt);
    }
}
__device__ void dil_merge_phase() {
    const Ctx c = make_ctx();
    const bf16_t* OG = c.w<bf16_t>(D_OG); const float* LS = c.w<float>(D_LSE); bf16_t* O = c.w<bf16_t>(D_O);
    for (size_t i = (size_t)c.vcu * NTHR + c.tid; i < (size_t)NTOK * 128; i += (size_t)c.G * NTHR) {
        const size_t tok = i >> 7; const int chunk = (int)(i & 127), head = chunk >> 3;
        const float l0 = LS[tok * 16 + head], l1 = LS[(size_t)NTOK * 16 + tok * 16 + head], l2 = LS[(size_t)2 * NTOK * 16 + tok * 16 + head];
        const float mx = fmaxf(l0, fmaxf(l1, l2));
        const float e0 = fast_exp2(l0 - mx), e1 = fast_exp2(l1 - mx), e2 = fast_exp2(l2 - mx), inv = fast_rcp(e0 + e1 + e2);
        const u32x4 a = *(const u32x4*)(OG + tok * 1024 + chunk * 8), bq = *(const u32x4*)(OG + (size_t)NTOK * 1024 + tok * 1024 + chunk * 8), cq = *(const u32x4*)(OG + (size_t)2 * NTOK * 1024 + tok * 1024 + chunk * 8);
        u32x4 o;
#pragma unroll
        for (int j = 0; j < 4; ++j) {
            const float lo = (bflo(a[j]) * e0 + bflo(bq[j]) * e1 + bflo(cq[j]) * e2) * inv, hi = (bfhi(a[j]) * e0 + bfhi(bq[j]) * e1 + bfhi(cq[j]) * e2) * inv;
            o[j] = cvt_pk_bf16(lo, hi);
        }
        *(u32x4*)(O + tok * 1024 + chunk * 8) = o;
    }
}

constexpr int GL_QG = 0, GL_KG = 17408, GL_KDT = 34816, GL_VT = 53248, GL_AS = 90112, GL_ALR = 99328, GL_SEG = 103424;
DEV float logsigmoid_(float z) {
    const float e = fast_exp2(-fabsf(z) * LOG2E);
    return fminf(z, 0.f) - __log2f(1.f + e) * 0.6931471805599453f;
}
__device__ void gla_a_phase(const float* w_a2, const float* b_a) {
    const Ctx c = make_ctx();
    const bf16_t* Qg = c.w<bf16_t>(G_Q); const bf16_t* Kg = c.w<bf16_t>(G_K); const float* ALR = c.w<float>(G_ALR); const bf16_t* VTg = c.w<bf16_t>(G_VT);
    float* OI = c.w<float>(G_OI); bf16_t* QGo = c.w<bf16_t>(G_QG); bf16_t* DST = c.w<bf16_t>(G_DST); float* DEC = c.w<float>(G_DEC);
    LAS bf16_t* sQG = (LAS bf16_t*)(c.lds + GL_QG); LAS bf16_t* sKG = (LAS bf16_t*)(c.lds + GL_KG);
    LAS bf16_t* sKDT = (LAS bf16_t*)(c.lds + GL_KDT);
    LAS bf16_t* sVT = (LAS bf16_t*)(c.lds + GL_VT);
    LAS bf16_t* sA = (LAS bf16_t*)(c.lds + GL_AS);
    LAS float* sALR = (LAS float*)(c.lds + GL_ALR);
    LAS float* sSEG = (LAS float*)(c.lds + GL_SEG);
    const int fr = c.lane & 15, fq = c.lane >> 4, w = c.wave;
    for (int unit = c.vcu; unit < NB * 64 * 4; unit += c.G) {
        const int hd = unit & 3, n = (unit >> 2) & 63, b = unit >> 8;
        const int tok0 = b * SEQ + n * 64;
        if (c.tid < 256) *(LAS f32x4*)(sALR + (c.tid >> 2) * 16 + (c.tid & 3) * 4) = *(const f32x4*)(ALR + (size_t)(tok0 + (c.tid >> 2)) * 16 + (c.tid & 3) * 4);
#pragma unroll
        for (int q = 0; q < 4; ++q) {
            const int id = c.tid + 512 * q, e = id >> 3, cc = (id & 7) * 8;
            *(LAS u32x4*)(sVT + e * 72 + cc) = *(const u32x4*)(VTg + ((size_t)(b * 1024 + hd * 256 + e)) * 4096 + n * 64 + cc);
        }
        __syncthreads();
        {
            const int d = c.tid & 127, seg = c.tid >> 7;
            float wa[16];
#pragma unroll
            for (int r = 0; r < 16; ++r) wa[r] = w_a2[r * 512 + hd * 128 + d];
            const float ba = b_a[hd * 128 + d];
            float cum[16]; float run = 0.f;
#pragma unroll
            for (int cc = 0; cc < 16; ++cc) {
                const LAS float* ar = sALR + (seg * 16 + cc) * 16;
                float z = ba;
#pragma unroll
                for (int r = 0; r < 16; ++r) z += ar[r] * wa[r];
                run += logsigmoid_(z) * (1.f / 16.f); cum[cc] = run;
            }
            sSEG[seg * 128 + d] = run;
            __syncthreads();
            float off = 0.f, blast = 0.f;
#pragma unroll
            for (int s = 0; s < 4; ++s) { const float v = sSEG[s * 128 + d]; off += (s < seg) ? v : 0.f; blast += v; }
#pragma unroll
            for (int cc = 0; cc < 16; ++cc) {
                const int cpos = seg * 16 + cc; const float bcd = cum[cc] + off;
                const float qv = bf2f(Qg[(size_t)(tok0 + cpos) * 512 + hd * 128 + d]), kv = bf2f(Kg[(size_t)(tok0 + cpos) * 512 + hd * 128 + d]);
                const float eb = fast_exp2(bcd * LOG2E);
                const bf16_t qg = f2bf(qv * eb * 0.08838834764831845f), kg = f2bf(kv * fast_rcp(eb)), kd = f2bf(kv * fast_exp2((blast - bcd) * LOG2E));
                sQG[cpos * 136 + d] = qg; sKG[cpos * 136 + d] = kg; sKDT[d * 72 + cpos] = kd;
                QGo[(size_t)(tok0 + cpos) * 512 + hd * 128 + d] = qg;
            }
            if (seg == 0) DEC[((size_t)((b * 64 + n) * 4 + hd)) * 128 + d] = fast_exp2(blast * LOG2E);
        }
        __syncthreads();
        {
            const int it = w >> 1;
#pragma unroll
            for (int jj = 0; jj < 2; ++jj) {
                const int jt = 2 * (w & 1) + jj;
                f32x4 acc = {0.f, 0.f, 0.f, 0.f};
#pragma unroll
                for (int ks = 0; ks < 4; ++ks) {
                    const bf16x8 a = *(const LAS bf16x8*)(sKG + (jt * 16 + fr) * 136 + ks * 32 + fq * 8);
                    const bf16x8 bq = *(const LAS bf16x8*)(sQG + (it * 16 + fr) * 136 + ks * 32 + fq * 8);
                    acc = __builtin_amdgcn_mfma_f32_16x16x32_bf16(a, bq, acc, 0, 0, 0);
                }
                const int i = it * 16 + fr, j0 = jt * 16 + fq * 4;
                u32x2 wv; wv.x = cvt_pk_bf16(i >= j0 ? acc[0] : 0.f, i >= j0 + 1 ? acc[1] : 0.f); wv.y = cvt_pk_bf16(i >= j0 + 2 ? acc[2] : 0.f, i >= j0 + 3 ? acc[3] : 0.f);
                *(LAS u32x2*)(sA + i * 72 + j0) = wv;
            }
        }
        __syncthreads();
        {
            const int e0 = w * 32;
            f32x4 acc[2][4];
#pragma unroll
            for (int et = 0; et < 2; ++et)
#pragma unroll
                for (int it = 0; it < 4; ++it) acc[et][it] = (f32x4){0.f, 0.f, 0.f, 0.f};
#pragma unroll
            for (int ks = 0; ks < 2; ++ks) {
                bf16x8 bi[4];
#pragma unroll
                for (int it = 0; it < 4; ++it) bi[it] = *(const LAS bf16x8*)(sA + (it * 16 + fr) * 72 + ks * 32 + fq * 8);
#pragma unroll
                for (int et = 0; et < 2; ++et) {
                    const bf16x8 a = *(const LAS bf16x8*)(sVT + (e0 + et * 16 + fr) * 72 + ks * 32 + fq * 8);
#pragma unroll
                    for (int it = 0; it < 4; ++it) acc[et][it] = __builtin_amdgcn_mfma_f32_16x16x32_bf16(a, bi[it], acc[et][it], 0, 0, 0);
                }
            }
#pragma unroll
            for (int et = 0; et < 2; ++et)
#pragma unroll
                for (int it = 0; it < 4; ++it)
                    *(f32x4*)(OI + (size_t)(tok0 + it * 16 + fr) * 1024 + hd * 256 + e0 + et * 16 + fq * 4) = acc[et][it];
        }
        {
            const int e0 = w * 32;
#pragma unroll
            for (int et = 0; et < 2; ++et) {
                f32x4 acc[8];
#pragma unroll
                for (int dt = 0; dt < 8; ++dt) acc[dt] = (f32x4){0.f, 0.f, 0.f, 0.f};
#pragma unroll
                for (int ks = 0; ks < 2; ++ks) {
                    const bf16x8 bq = *(const LAS bf16x8*)(sVT + (e0 + et * 16 + fr) * 72 + ks * 32 + fq * 8);
#pragma unroll
                    for (int dt = 0; dt < 8; ++dt) {
                        const bf16x8 a = *(const LAS bf16x8*)(sKDT + (dt * 16 + fr) * 72 + ks * 32 + fq * 8);
                        acc[dt] = __builtin_amdgcn_mfma_f32_16x16x32_bf16(a, bq, acc[dt], 0, 0, 0);
                    }
                }
                bf16_t* dp = DST + (((size_t)((b * 4 + hd) * 64 + n)) * 256 + e0 + et * 16 + fr) * 128 + fq * 4;
#pragma unroll
                for (int dt = 0; dt < 8; ++dt) { u32x2 wv; wv.x = cvt_pk_bf16(acc[dt][0], acc[dt][1]); wv.y = cvt_pk_bf16(acc[dt][2], acc[dt][3]); *(u32x2*)(dp + dt * 16) = wv; }
            }
        }
        __syncthreads();
    }
}

__device__ void gla_b_phase() {
    const Ctx c = make_ctx();
    float* OI = c.w<float>(G_OI); const bf16_t* QG = c.w<bf16_t>(G_QG); const bf16_t* DST = c.w<bf16_t>(G_DST); const float* DEC = c.w<float>(G_DEC);
    const int fr = c.lane & 15, fq = c.lane >> 4, NW = c.G * NWAVE, wg = c.vcu * NWAVE + c.wave;
    for (int I = wg; I < 2048; I += NW) {
        const int it = I & 3, et = (I >> 2) & 15, hd = (I >> 6) & 3, b = I >> 8;
        float S[4][8];
#pragma unroll
        for (int ks = 0; ks < 4; ++ks)
#pragma unroll
            for (int j = 0; j < 8; ++j) S[ks][j] = 0.f;
        const bf16_t* qp = QG + (size_t)(b * SEQ + it * 16 + fr) * 512 + hd * 128 + fq * 8;
        const bf16_t* dp = DST + (((size_t)(b * 4 + hd) * 64) * 256 + et * 16 + fr) * 128 + fq * 8;
        const float* cp = DEC + ((size_t)(b * 64) * 4 + hd) * 128 + fq * 8;
        float* op = OI + (size_t)(b * SEQ + it * 16 + fq * 4) * 1024 + hd * 256 + et * 16 + fr;
        for (int n = 0; n < 64; ++n) {
            bf16x8 qf[4]; u32x4 ds[4]; f32x4 dc[4][2];
#pragma unroll
            for (int ks = 0; ks < 4; ++ks) {
                qf[ks] = *(const bf16x8*)(qp + (size_t)n * 64 * 512 + ks * 32);
                ds[ks] = *(const u32x4*)(dp + (size_t)n * 256 * 128 + ks * 32);
                dc[ks][0] = *(const f32x4*)(cp + (size_t)n * 512 + ks * 32); dc[ks][1] = *(const f32x4*)(cp + (size_t)n * 512 + ks * 32 + 4);
            }
            f32x4 acc = {0.f, 0.f, 0.f, 0.f};
#pragma unroll
            for (int ks = 0; ks < 4; ++ks) {
                u32x4 sw; sw.x = cvt_pk_bf16(S[ks][0], S[ks][1]); sw.y = cvt_pk_bf16(S[ks][2], S[ks][3]); sw.z = cvt_pk_bf16(S[ks][4], S[ks][5]); sw.w = cvt_pk_bf16(S[ks][6], S[ks][7]);
                acc = __builtin_amdgcn_mfma_f32_16x16x32_bf16(qf[ks], __builtin_bit_cast(bf16x8, sw), acc, 0, 0, 0);
            }
#pragma unroll
            for (int r = 0; r < 4; ++r) { float* o = op + (size_t)(n * 64 + r) * 1024; *o = *o + acc[r]; }
#pragma unroll
            for (int ks = 0; ks < 4; ++ks) {
#pragma unroll
                for (int j = 0; j < 4; ++j) {
                    S[ks][2 * j] = dc[ks][j >> 1][(2 * j) & 3] * S[ks][2 * j] + bflo(ds[ks][j]);
                    S[ks][2 * j + 1] = dc[ks][j >> 1][(2 * j + 1) & 3] * S[ks][2 * j + 1] + bfhi(ds[ks][j]);
                }
            }
        }
    }
}

__device__ void gla_c_phase(const float* norm_g) {
    const Ctx c = make_ctx();
    const float* OI = c.w<float>(G_OI); const bf16_t* R = c.w<bf16_t>(G_R); bf16_t* GO = c.w<bf16_t>(G_O);
    const f32x4 gv = *(const f32x4*)(norm_g + c.lane * 4);
    const int NW = c.G * NWAVE, wg = c.vcu * NWAVE + c.wave;
    for (int I = wg; I < NTOK * 4; I += NW) {
        const size_t off = (size_t)(I >> 2) * 1024 + (I & 3) * 256 + c.lane * 4;
        const f32x4 v = *(const f32x4*)(OI + off);
        const float ss = wave_sum((v[0] * v[0] + v[1] * v[1]) + (v[2] * v[2] + v[3] * v[3]), c.lane);
        const float rs = __builtin_amdgcn_rsqf(ss * (1.f / 256.f) + LN_EPS);
        const u32x2 rw = *(const u32x2*)(R + off);
        u32x2 o; o.x = cvt_pk_bf16(v[0] * rs * gv[0] * bflo(rw.x), v[1] * rs * gv[1] * bfhi(rw.x)); o.y = cvt_pk_bf16(v[2] * rs * gv[2] * bflo(rw.y), v[3] * rs * gv[3] * bfhi(rw.y));
        *(u32x2*)(GO + off) = o;
    }
}

enum { S_END = 0, S_CONV_NSA, S_CMP2, S_NSA_ATTN, S_CONV_GLA, S_GLA_A, S_GLA_B, S_GLA_C, S_CONV_DIL, S_DIL_ATTN, S_DIL_MERGE, S_LN1, S_ROUTE_A, S_ROUTE_B, S_LN2,
       S_GEMM0 = 32, S_G_NSA_A = 32, S_G_NSA_V, S_G_CMP1, S_G_WOUT_N, S_G_GLA_A, S_G_GLA_V, S_G_WOUT_G, S_G_DIL_A, S_G_DIL_V, S_G_WOUT_D, S_G_MOE1, S_G_MOE2 };
__device__ const unsigned char STEPS[3][16] = {
    {S_CONV_NSA, S_G_NSA_A, S_G_NSA_V, S_G_CMP1, S_CMP2, S_NSA_ATTN, S_G_WOUT_N, S_LN1, S_ROUTE_A, S_ROUTE_B, S_G_MOE1, S_G_MOE2, S_LN2, S_END, S_END, S_END},
    {S_CONV_GLA, S_G_GLA_A, S_G_GLA_V, S_GLA_A, S_GLA_B, S_GLA_C, S_G_WOUT_G, S_LN1, S_ROUTE_A, S_ROUTE_B, S_G_MOE1, S_G_MOE2, S_LN2, S_END, S_END, S_END},
    {S_CONV_DIL, S_G_DIL_A, S_G_DIL_V, S_DIL_ATTN, S_DIL_MERGE, S_G_WOUT_D, S_LN1, S_ROUTE_A, S_ROUTE_B, S_G_MOE1, S_G_MOE2, S_LN2, S_END, S_END, S_END, S_END},
};

__device__ void cmp_bias(const float* pos0, const float* w10, const float* pos1, const float* w11) {
    const Ctx c = make_ctx();
    float* bias = c.w<float>(WS_BIAS);
    for (int which = c.vcu; which < 2; which += c.G) {
        const float* pos = which ? pos1 : pos0; const float* w1 = which ? w11 : w10;
        LAS float* red = (LAS float*)c.lds;
        const int j = c.tid & 255, half = c.tid >> 8;
        float s = 0.f;
        for (int k = half * 1024; k < half * 1024 + 1024; ++k) s += pos[k] * w1[(size_t)k * 256 + j];
        red[c.tid] = s;
        __syncthreads();
        if (c.tid < 256) bias[which * 256 + j] = red[j] + red[256 + j];
        __syncthreads();
    }
}

DEV void conv_moe(int lb  ) {
    const Ctx c = make_ctx();
    ConvJob j;
    j.src = c.in(lb + 4); j.dst = c.w<bf16_t>(WS_WE1); j.ldn = 512; j.K = 1024; j.ntn = 8; j.nvalid = 512; j.nbatch = 64; j.sbatch = (size_t)1024 * 512; j.dbatch = (size_t)512 * 1024; j.mode = 1; j.col0 = 0;
    conv_run(j);
    j.src = c.in(lb + 6); j.dst = c.w<bf16_t>(WS_WE1) + (size_t)64 * 512 * 1024; j.nbatch = 1;
    conv_run(j);
    j.src = c.in(lb + 5); j.dst = c.w<bf16_t>(WS_WE2); j.ldn = 1024; j.K = 256; j.ntn = 16; j.nvalid = 1024; j.nbatch = 64; j.sbatch = (size_t)256 * 1024; j.dbatch = (size_t)1024 * 256; j.mode = 0; j.col0 = 0;
    conv_run(j);
    j.src = c.in(lb + 7); j.dst = c.w<bf16_t>(WS_WE2) + (size_t)64 * 1024 * 256; j.nbatch = 1;
    conv_run(j);
    conv_router(c.in(lb + 2), c.w<bf16_t>(WS_WR));
}

static_assert(sizeof(GemmDesc) <= 192, "GemmDesc slot");
DEV void gemm_table() {
    const Ctx c = make_ctx();
    if (c.tid < 12) {
        const int step = S_GEMM0 + c.tid;
        bf16_t* XB = c.w<bf16_t>(WS_XB); bf16_t* WM = c.w<bf16_t>(WS_WMIX); int* meta = c.w<int>(WS_META);
        LAS GemmDesc& d = *(LAS GemmDesc*)(c.lds + LDS_DESC + c.tid * 192);
        d.lda = 1024; d.ldb = 1024; d.K = 1024; d.kstepA = 64; d.nM = 128; d.nN = 4; d.nM_ptr = nullptr; d.amode = AM_ID; d.aidx = nullptr; d.bmode = BM_ID; d.tile_e = nullptr; d.bstride = 0;
        d.o0 = nullptr; d.o1 = nullptr; d.o2 = nullptr; d.o3 = nullptr; d.f0 = nullptr; d.f1 = nullptr; d.A = XB; d.Bt = WM; d.epi = EPI_WOUT;
        switch (step) {
        case S_G_NSA_A: d.Bt = WM + NW_A; d.nN = 9; d.epi = EPI_NSA_A; d.o0 = c.w<void>(N_Q); d.o1 = c.w<void>(N_KCVC); d.o2 = c.w<void>(N_GATE); break;
        case S_G_NSA_V: d.A = WM + NW_V; d.Bt = XB; d.nM = 2; d.nN = 128; d.epi = EPI_NSA_V; d.o0 = c.w<void>(N_VTS); break;
        case S_G_CMP1:  d.A = c.w<bf16_t>(N_KCVC); d.lda = 16 * 256; d.kstepA = 256; d.amode = AM_CMP; d.K = 2048; d.Bt = WM + NW_W1; d.ldb = 2048; d.bmode = BM_EXP; d.tile_e = meta + META_TILE + 1280; d.bstride = (size_t)256 * 2048;
                        d.nM = 64; d.nN = 1; d.epi = EPI_CMP1; d.o0 = c.w<void>(N_HC); d.f0 = c.w<float>(WS_BIAS); break;
        case S_G_WOUT_N: d.A = c.w<bf16_t>(N_O); d.Bt = WM + NW_OUT; d.o0 = c.xf; break;
        case S_G_GLA_A: d.Bt = WM + GW_A; d.nN = 9; d.epi = EPI_GLA_A; d.o0 = c.w<void>(G_Q); d.o1 = c.w<void>(G_R); d.o2 = c.w<void>(G_ALR); break;
        case S_G_GLA_V: d.A = WM + GW_V; d.Bt = XB; d.nM = 4; d.nN = 128; d.epi = EPI_GLA_V; d.o0 = c.w<void>(G_VT); break;
        case S_G_WOUT_G: d.A = c.w<bf16_t>(G_O); d.Bt = WM + GW_OUT; d.o0 = c.xf; break;
        case S_G_DIL_A: d.Bt = WM + DW_A; d.nN = 24; d.epi = EPI_DIL_A; d.o0 = c.w<void>(D_Q); d.o1 = c.w<void>(D_K); break;
        case S_G_DIL_V: d.A = WM + DW_V; d.Bt = XB; d.nM = 12; d.nN = 128; d.bmode = BM_DIL; d.epi = EPI_DIL_V; d.o0 = c.w<void>(D_VT); break;
        case S_G_WOUT_D: d.A = c.w<bf16_t>(D_O); d.Bt = WM + DW_OUT; d.o0 = c.xf; break;
        case S_G_MOE1:  d.A = XB; d.amode = AM_IDX; d.aidx = c.w<int>(A_ROWTOK); d.Bt = c.w<bf16_t>(WS_WE1); d.bmode = BM_EXP; d.tile_e = meta + META_TILE; d.bstride = (size_t)512 * 1024;
                        d.nM_ptr = meta + META_NMT; d.nN = 2; d.epi = EPI_MOE1; d.o0 = c.w<void>(A_H); break;
        case S_G_MOE2:  d.A = c.w<bf16_t>(A_H); d.lda = 256; d.K = 256; d.Bt = c.w<bf16_t>(WS_WE2); d.ldb = 256; d.bmode = BM_EXP; d.tile_e = meta + META_TILE; d.bstride = (size_t)1024 * 256;
                        d.nM_ptr = meta + META_NMT; d.nN = 4; d.epi = EPI_MOE2; d.o0 = c.w<void>(A_Y); d.o1 = c.xf; d.o2 = c.w<void>(A_ROWTOK); d.f0 = c.w<float>(A_ROWGATE); break;
        default: break;
        }
    }
    __syncthreads();
}

DEV void conv_nsa(int mb) {
    const Ctx c = make_ctx(); bf16_t* WM = c.w<bf16_t>(WS_WMIX);
    const float* win = c.in(mb);
    conv(win, 2608, 0, 1280, 1280, 1024, WM + NW_A);
    conv(win, 2608, 1280, 256, 256, 1024, WM + NW_A + (size_t)1280 * 1024);
    conv(win, 2608, 1536, 256, 256, 1024, WM + NW_A + (size_t)1536 * 1024);
    conv(win, 2608, 2048, 256, 256, 1024, WM + NW_A + (size_t)1792 * 1024);
    conv(win, 2608, 2560, 48, 256, 1024, WM + NW_A + (size_t)2048 * 1024);
    conv(win, 2608, 1792, 256, 256, 1024, WM + NW_V);
    conv(win, 2608, 2304, 256, 256, 1024, WM + NW_V + (size_t)256 * 1024);
    conv(c.in(mb + 3), 256, 0, 256, 256, 2048, WM + NW_W1);
    conv(c.in(mb + 6), 256, 0, 256, 256, 2048, WM + NW_W1 + (size_t)256 * 2048);
    conv(c.in(mb + 1), 1024, 0, 1024, 1024, 1024, WM + NW_OUT);
    conv(c.in(mb + 4), 64, 0, 64, 64, 256, WM + NW_W2);
    conv(c.in(mb + 7), 64, 0, 64, 64, 256, WM + NW_W2 + (size_t)64 * 256);
    cmp_bias(c.in(mb + 2), c.in(mb + 3), c.in(mb + 5), c.in(mb + 6));
}
DEV void conv_gla(int mb) {
    const Ctx c = make_ctx(); bf16_t* WM = c.w<bf16_t>(WS_WMIX);
    const float* win = c.in(mb);
    conv(win, 3088, 0, 1024, 1024, 1024, WM + GW_A);
    conv(win, 3088, 2064, 1024, 1024, 1024, WM + GW_A + (size_t)1024 * 1024);
    conv(win, 3088, 2048, 16, 256, 1024, WM + GW_A + (size_t)2048 * 1024);
    conv(win, 3088, 1024, 1024, 1024, 1024, WM + GW_V);
    conv(c.in(mb + 4), 1024, 0, 1024, 1024, 1024, WM + GW_OUT);
}
DEV void conv_dil(int mb) {
    const Ctx c = make_ctx(); bf16_t* WM = c.w<bf16_t>(WS_WMIX);
    const float* win = c.in(mb);
    for (int g = 0; g < 3; ++g) {
        conv(win, 9216, g * 3072, 2048, 2048, 1024, WM + DW_A + (size_t)g * 2048 * 1024);
        conv(win, 9216, g * 3072 + 2048, 1024, 1024, 1024, WM + DW_V + (size_t)g * 1024 * 1024);
    }
    conv(c.in(mb + 1), 1024, 0, 1024, 1024, 1024, WM + DW_OUT);
}
DEV const float* inptr(int i) { const Ctx c = make_ctx(); return c.in(i); }

__global__ void __launch_bounds__(NTHR, 2) fwd(Args args) {
    extern __shared__ __attribute__((aligned(16))) unsigned char lds_raw[];
    LAS unsigned char* lds = (LAS unsigned char*)lds_raw;
    if (threadIdx.x < 4) ((LAS unsigned*)(lds + LDS_MISC))[threadIdx.x] = 0u;
    if (threadIdx.x == 0) {
        *(unsigned char* LAS*)(lds + LDS_MISC + 16) = args.ws; *(float* LAS*)(lds + LDS_MISC + 24) = args.out;
#pragma unroll
        for (int i = 0; i < 64; ++i) ((const float* LAS*)(lds + LDS_MISC + 64))[i] = args.in[i];
    }
    __syncthreads();
    { const Ctx c = make_ctx(); (void)xcd_barrier_post((unsigned*)c.ws + CW_BAR, (volatile LAS unsigned*)(lds + LDS_MISC));
      if (c.vcu == 0 && c.tid < 64) c.w<int>(WS_META)[META_TILE + 1280 + c.tid] = c.tid >> 5;
      if (c.tid == 0) *(LAS int*)(lds + LDS_MISC + 32) = 0; }
    gemm_table();
    prologue();
    for (;;) {
        __syncthreads();
        int pc = *(volatile LAS int*)(lds + LDS_MISC + 32);
        pc = __builtin_amdgcn_readfirstlane(pc);
        const int L = pc >> 4, si = pc & 15;
        if (L >= 4) break;
        const int kind = (L == 3) ? 0 : L;
        const int mb = (L == 0) ? 1 : (L == 1) ? 19 : (L == 2) ? 34 : 46;
        const int lb = (L == 0) ? 9 : (L == 1) ? 24 : (L == 2) ? 36 : 54;
        const int step = STEPS[kind][si];
        __syncthreads();
        if (threadIdx.x == 0) *(volatile LAS int*)(lds + LDS_MISC + 32) = (step == S_END || si == 15) ? (L + 1) * 16 : pc + 1;
        if (step == S_END) continue;
        if (step >= S_GEMM0) gemm_phase(step - S_GEMM0);
        else {
            switch (step) {
            case S_CONV_NSA: conv_nsa(mb); break;
            case S_CMP2: nsa_cmp2_phase(); break;
            case S_NSA_ATTN: nsa_attn_phase(); break;
            case S_CONV_GLA: conv_gla(mb); break;
            case S_GLA_A: gla_a_phase(inptr(mb + 1), inptr(mb + 2)); break;
            case S_GLA_B: gla_b_phase(); break;
            case S_GLA_C: gla_c_phase(inptr(mb + 3)); break;
            case S_CONV_DIL: conv_dil(mb); break;
            case S_DIL_ATTN: dil_attn_phase(); break;
            case S_DIL_MERGE: dil_merge_phase(); break;
            case S_LN1: ln_phase<0>(inptr(lb), inptr(lb + 1)); conv_moe(lb); break;
            case S_ROUTE_A: route_a(inptr(lb + 3)); break;
            case S_ROUTE_B: route_b(); break;
            case S_LN2: ln_phase<1>(inptr(lb + 8), inptr(lb + 9)); break;
            default: break;
            }
        }
        { const Ctx c = make_ctx(); XcdBarrier bar; bar.bar = (unsigned*)c.ws + CW_BAR; bar.x = xb_xcc_id(); bar.st = (volatile LAS unsigned*)(c.lds + LDS_MISC); xcd_barrier(bar); }
    }
}

extern "C" void kernel_launch(void* const* d_in, const int* in_sizes, int n_in, void* d_out, int out_size, void* d_ws, size_t ws_size, hipStream_t stream) {
    static int grid = 0;
    if (grid == 0) {
        if (n_in != 64 || out_size != NTOK * DM || ws_size < WS_NEED) { fprintf(stderr, "kernel_launch: unexpected problem (n_in %d, out %d, ws %zu, need %zu)\n", n_in, out_size, ws_size, (size_t)WS_NEED); grid = -1; return; }
        int dev = 0, cus = 0, per_cu = 0;
        if (hipGetDevice(&dev) != hipSuccess || hipDeviceGetAttribute(&cus, hipDeviceAttributeMultiprocessorCount, dev) != hipSuccess) { grid = -1; return; }
        if (hipFuncSetAttribute((const void*)fwd, hipFuncAttributeMaxDynamicSharedMemorySize, LDS_BYTES) != hipSuccess) { fprintf(stderr, "kernel_launch: hipFuncSetAttribute failed\n"); grid = -1; return; }
        if (hipOccupancyMaxActiveBlocksPerMultiprocessor(&per_cu, (const void*)fwd, NTHR, LDS_BYTES) != hipSuccess || per_cu < 1) { fprintf(stderr, "kernel_launch: occupancy query says %d\n", per_cu); }
        (void)hipGetLastError();
        grid = cus;
    }
    if (grid < 0) return;
    (void)in_sizes;
    if (hipMemsetAsync(d_ws, 0, CTL_BYTES, stream) != hipSuccess) return;
    Args a;
    for (int i = 0; i < 64; ++i) a.in[i] = (const float*)d_in[i];
    a.out = (float*)d_out; a.ws = (unsigned char*)d_ws;
    hipLaunchKernelGGL(fwd, dim3(grid), dim3(NTHR), LDS_BYTES, stream, a);
}
```

```cpp
#include <hip/hip_runtime.h>
#include <stdint.h>
#include <stdio.h>

#ifndef DIAG
#define DIAG 0
#endif

typedef unsigned short bf16_t;
typedef short bf16x8 __attribute__((ext_vector_type(8)));
typedef float f32x4 __attribute__((ext_vector_type(4)));
typedef float f32x2 __attribute__((ext_vector_type(2)));
typedef float f32x16 __attribute__((ext_vector_type(16)));
typedef unsigned u32x4 __attribute__((ext_vector_type(4)));
typedef unsigned u32x2 __attribute__((ext_vector_type(2)));
#define LAS __attribute__((address_space(3)))
#define DEV __device__ __forceinline__

constexpr int NTOK = 32768, SEQ = 4096, NB = 8, DM = 1024;
constexpr int NTHR = 512, NWAVE = 8;
constexpr float DN_ALPHA = 1.681792830507429f;
constexpr float LN_EPS = 1e-5f;
constexpr float LOG2E = 1.4426950408889634f;
constexpr float QSCALE = 0.125f * LOG2E;

DEV unsigned cvt_pk_bf16(float lo, float hi) { unsigned r; asm volatile("v_cvt_pk_bf16_f32 %0, %1, %2" : "=v"(r) : "v"(lo), "v"(hi)); return r; }
DEV bf16_t f2bf(float x) { return (bf16_t)(cvt_pk_bf16(x, 0.f) & 0xffffu); }
DEV float bf2f(bf16_t b) { return __uint_as_float(((unsigned)b) << 16); }
DEV float bflo(unsigned w) { return __uint_as_float(w << 16); }
DEV float bfhi(unsigned w) { return __uint_as_float(w & 0xffff0000u); }
DEV float fast_exp2(float x) { return __builtin_amdgcn_exp2f(x); }
DEV float fast_rcp(float x) { return __builtin_amdgcn_rcpf(x); }
DEV float sigmoidf_(float x) { return fast_rcp(1.f + fast_exp2(-x * LOG2E)); }
DEV float siluf_(float x) { return x * sigmoidf_(x); }
DEV float gelu_tanh(float x) {
    const float u = 0.7978845608028654f * (x + 0.044715f * x * x * x);
    const float t = 1.f - 2.f * fast_rcp(1.f + fast_exp2(2.f * LOG2E * u));
    return 0.5f * x * (1.f + t);
}
template <int X> DEV float swz_xor(float v) { return __int_as_float(__builtin_amdgcn_ds_swizzle(__float_as_int(v), 0x1F | (X << 10))); }
template <int X> DEV int swz_xor_i(int v) { return __builtin_amdgcn_ds_swizzle(v, 0x1F | (X << 10)); }
DEV float bperm_f(int srclane, float v) { return __int_as_float(__builtin_amdgcn_ds_bpermute(srclane << 2, __float_as_int(v))); }
DEV int bperm_i(int srclane, int v) { return __builtin_amdgcn_ds_bpermute(srclane << 2, v); }
DEV float xor32_f(float v, int lane) { return bperm_f(lane ^ 32, v); }
DEV float wave_sum(float v, int lane) {
    v += swz_xor<1>(v); v += swz_xor<2>(v); v += swz_xor<4>(v); v += swz_xor<8>(v); v += swz_xor<16>(v); v += xor32_f(v, lane);
    return v;
}

#define XB_TMO      128
#define XB_XCNT(j)  (256  + 64 * (j))
#define XB_XSUB(j)  (1280 + 64 * (j))
#define XB_XGEN(j)  (2304 + 64 * (j))
#define XB_TOP      3328
#define XB_TOPGEN   3392
#define XCD_BAR_WORDS 3456
#define XB_SPIN_CAP (1u << 18)

__device__ __forceinline__ unsigned xb_ld(unsigned* p)              { return __hip_atomic_load(p, __ATOMIC_RELAXED, __HIP_MEMORY_SCOPE_AGENT); }
__device__ __forceinline__ unsigned xb_add(unsigned* p, unsigned v) { return __hip_atomic_fetch_add(p, v, __ATOMIC_RELAXED, __HIP_MEMORY_SCOPE_AGENT); }
__device__ __forceinline__ unsigned xb_xcc_id() { return (unsigned)__builtin_amdgcn_s_getreg((3 << 11) | 20) & 0xFu; }
#define XB_SPIN(cond, bar) do { unsigned _sp = 0; while (cond) { __builtin_amdgcn_s_sleep(1); \
    if ((++_sp & 255u) == 0u) { if (xb_ld(&(bar)[XB_TMO])) break; if (_sp > XB_SPIN_CAP) { atomicAdd(&(bar)[XB_TMO], 1u); break; } } } } while (0)

struct XcdBarrier { unsigned* bar; unsigned x; volatile LAS unsigned* st; };

__device__ __forceinline__ XcdBarrier xcd_barrier_post(unsigned* bar, volatile LAS unsigned* st) {
    XcdBarrier b; b.bar = bar; b.x = xb_xcc_id(); b.st = st;
    if (threadIdx.x == 0) (void)xb_add(&bar[XB_XCNT(b.x)], 1u);
    return b;
}
__device__ __forceinline__ void xcd_barrier_complete(unsigned* bar, unsigned x, unsigned& nloc, unsigned& nx) {
    const unsigned G = gridDim.x * gridDim.y * gridDim.z;
    unsigned sum, cnt, mine, sp = 0u;
    for (;;) {
        sum = 0u; cnt = 0u; mine = 0u;
#pragma unroll
        for (unsigned j = 0; j < 16; ++j) { const unsigned c = xb_ld(&bar[XB_XCNT(j)]); sum += c; cnt += (c > 0u) ? 1u : 0u; mine = (j == x) ? c : mine; }
        if (sum == G) break;
        __builtin_amdgcn_s_sleep(1);
        if ((++sp & 255u) == 0u) { if (xb_ld(&bar[XB_TMO])) break; if (sp > XB_SPIN_CAP) { atomicAdd(&bar[XB_TMO], 1u); break; } }
    }
    nloc = mine > 0u ? mine : 1u; nx = cnt > 0u ? cnt : 1u;
}
__device__ __forceinline__ void xcd_barrier(const XcdBarrier& b) {
    asm volatile("s_waitcnt vmcnt(0)" ::: "memory");
    __syncthreads();
    if (threadIdx.x == 0) {
        unsigned* bar = b.bar;
        __builtin_amdgcn_s_waitcnt(0);
        unsigned nloc = b.st[0], nx = b.st[1];
        if (nloc == 0u) { xcd_barrier_complete(bar, b.x, nloc, nx); b.st[0] = nloc; b.st[1] = nx; }
        const unsigned old = xb_add(&bar[XB_XSUB(b.x)], 1u);
        const unsigned gen = old / nloc;
        if (old + 1u == (gen + 1u) * nloc) {
            __builtin_amdgcn_fence(__ATOMIC_RELEASE, "agent");
            asm volatile("s_waitcnt vmcnt(0)" ::: "memory");
            const unsigned og = xb_add(&bar[XB_TOP], 1u);
            const unsigned tg = og / nx;
            if (og + 1u == (tg + 1u) * nx) xb_add(&bar[XB_TOPGEN], 1u);
            else XB_SPIN(xb_ld(&bar[XB_TOPGEN]) == tg, bar);
            __builtin_amdgcn_fence(__ATOMIC_ACQUIRE, "agent");
            xb_add(&bar[XB_XGEN(b.x)], 1u);
            asm volatile("s_waitcnt vmcnt(0)" ::: "memory");
        } else {
            XB_SPIN(xb_ld(&bar[XB_XGEN(b.x)]) == gen, bar);
            __builtin_amdgcn_fence(__ATOMIC_ACQUIRE, "agent");
            asm volatile("s_waitcnt vmcnt(0)" ::: "memory");
        }
    }
    __syncthreads();
}

constexpr size_t MB = 1024ull * 1024ull;
constexpr size_t WS_CTL = 0;
constexpr int    CW_BAR = 0;
constexpr int    CW_DIAG = 4096;
constexpr size_t CTL_BYTES = 64 * 1024;
constexpr size_t WS_ROPE = 64 * 1024;
constexpr size_t WS_META = WS_ROPE + 256 * 1024;
constexpr int    META_CNT = 0, META_SEG = 256 * 64, META_NMT = META_SEG + 80, META_TILE = META_NMT + 16;
constexpr size_t WS_BIAS = WS_META + 128 * 1024;
constexpr size_t WS_XB = 1 * MB;
constexpr size_t XB_BYTES = (size_t)(NTOK + 256) * DM * 2;
constexpr size_t WS_WMIX = WS_XB + ((XB_BYTES + MB - 1) / MB) * MB;
constexpr size_t WMIX_BYTES = 24 * MB;
constexpr size_t WS_WMOE = WS_WMIX + WMIX_BYTES;
constexpr size_t WE1_ELEMS = (size_t)65 * 512 * 1024;
constexpr size_t WE2_ELEMS = (size_t)65 * 1024 * 256;
constexpr size_t WS_WE1 = WS_WMOE, WS_WE2 = WS_WE1 + WE1_ELEMS * 2, WS_WR = WS_WE2 + WE2_ELEMS * 2;
constexpr size_t WMOE_BYTES = ((WE1_ELEMS + WE2_ELEMS) * 2 + 64 * 1024 * 2 + MB - 1) / MB * MB;
constexpr size_t WS_ACT = WS_WMOE + WMOE_BYTES;

constexpr int    MOE_ROWS_R = 262144 + 64 * 256;
constexpr int    MOE_ROWS = MOE_ROWS_R + NTOK;
constexpr size_t A_PE = WS_ACT, A_PG = A_PE + 1 * MB, A_PR = A_PG + 1 * MB, A_POS = A_PR + 1 * MB;
constexpr size_t A_ROWTOK = A_POS + 1 * MB, A_ROWGATE = A_ROWTOK + 2 * MB;
constexpr size_t A_H = A_ROWGATE + 2 * MB;
constexpr size_t A_Y = A_H + ((size_t)MOE_ROWS * 256 * 2 + MB - 1) / MB * MB;
constexpr size_t MOE_END = A_Y + (size_t)MOE_ROWS_R * 1024 * 2;
constexpr size_t N_Q = WS_ACT;
constexpr size_t N_KCVC = N_Q + 64 * MB;
constexpr size_t N_KS = N_KCVC + 32 * MB, N_KW = N_KS + 16 * MB;
constexpr size_t N_VTS = N_KW + 16 * MB, N_VTW = N_VTS + 16 * MB;
constexpr size_t N_GATE = N_VTW + 16 * MB;
constexpr size_t N_HC = N_GATE + 8 * MB;
constexpr size_t N_KCMP = N_HC + 8 * MB;
constexpr size_t N_VCMPT = N_KCMP + 1 * MB;
constexpr size_t N_O = N_VCMPT + 1 * MB;
constexpr size_t NSA_END = N_O + 64 * MB;
constexpr size_t G_Q = WS_ACT, G_K = G_Q + 32 * MB;
constexpr size_t G_R = G_K + 32 * MB;
constexpr size_t G_ALR = G_R + 64 * MB;
constexpr size_t G_VT = G_ALR + 2 * MB;
constexpr size_t G_OI = G_VT + 64 * MB;
constexpr size_t G_QG = G_OI + 128 * MB;
constexpr size_t G_DST = G_QG + 32 * MB;
constexpr size_t G_DEC = G_DST + 128 * MB;
constexpr size_t G_O = G_DEC + 1 * MB;
constexpr size_t GLA_END = G_O + 64 * MB;
constexpr size_t D_Q = WS_ACT, D_K = D_Q + 192 * MB;
constexpr size_t D_VT = D_K + 192 * MB;
constexpr size_t D_OG = D_VT + 192 * MB;
constexpr size_t D_LSE = D_OG + 192 * MB;
constexpr size_t D_O = D_Q;
constexpr size_t DIL_END = D_LSE + 6 * MB;
constexpr size_t WS_NEED = (MOE_END > DIL_END ? MOE_END : DIL_END) > (NSA_END > GLA_END ? NSA_END : GLA_END) ? (MOE_END > DIL_END ? MOE_END : DIL_END) : (NSA_END > GLA_END ? NSA_END : GLA_END);

constexpr size_t NW_A = 0, NW_V = NW_A + (size_t)2304 * 1024, NW_W1 = NW_V + (size_t)512 * 1024, NW_OUT = NW_W1 + (size_t)2 * 256 * 2048, NW_W2 = NW_OUT + (size_t)1024 * 1024;
constexpr size_t GW_A = 0, GW_V = GW_A + (size_t)2304 * 1024, GW_OUT = GW_V + (size_t)1024 * 1024;
constexpr size_t DW_A = 0, DW_V = DW_A + (size_t)6144 * 1024, DW_OUT = DW_V + (size_t)3072 * 1024;
static_assert((DW_OUT + 1024 * 1024) * 2 <= WMIX_BYTES, "WMIX too small");

constexpr int LDS_MAIN = 131072;
constexpr int LDS_MISC = LDS_MAIN;
constexpr int LDS_DESC = LDS_MISC + 1024;
constexpr int LDS_BYTES = LDS_MAIN + 1024 + 16 * 192;

struct Args { const float* in[64]; float* out; unsigned char* ws; };

struct Ctx {
    LAS unsigned char* lds;
    unsigned char* ws;
    float* xf;
    int tid, lane, wave, G, vcu;
    DEV const float* in(int i) const { return ((const float* const LAS*)(lds + LDS_MISC + 64))[i]; }
    template <class T> DEV T* w(size_t off) const { return (T*)(ws + off); }
};
DEV unsigned long long uni64(unsigned long long v) {
    const unsigned lo = __builtin_amdgcn_readfirstlane((unsigned)v), hi = __builtin_amdgcn_readfirstlane((unsigned)(v >> 32));
    return ((unsigned long long)hi << 32) | lo;
}
DEV int uni(int v) { return __builtin_amdgcn_readfirstlane(v); }
template <class T> DEV T* unip(T* p) { return (T*)uni64((unsigned long long)p); }
DEV Ctx make_ctx() {
    extern __shared__ __attribute__((aligned(16))) unsigned char lds_raw[];
    Ctx c;
    { unsigned lb = 0u; asm volatile("" : "+s"(lb)); c.lds = (LAS unsigned char*)lds_raw + lb; }
    {
        unsigned long long w = uni64((unsigned long long)*(unsigned char* LAS*)(c.lds + LDS_MISC + 16)), o = uni64((unsigned long long)*(float* LAS*)(c.lds + LDS_MISC + 24));
        asm volatile("" : "+s"(w), "+s"(o));
        c.ws = (unsigned char*)w; c.xf = (float*)o;
    }
    int tz_ = threadIdx.x; asm volatile("" : "+v"(tz_));
    c.tid = tz_; c.lane = c.tid & 63; c.wave = uni(c.tid >> 6);
    { int g = gridDim.x, bx = blockIdx.x; asm volatile("" : "+s"(g), "+s"(bx)); c.G = g; c.vcu = (g % 8 == 0) ? (bx % 8) * (g / 8) + bx / 8 : bx; }
    return c;
}

struct ConvJob {
    const float* src; bf16_t* dst; int ldn, K, ntn, nvalid, nbatch; size_t sbatch, dbatch; int mode; int col0;
};
DEV int conv_srccol(const ConvJob& j, int nt) {
    const int n = nt * 64;
    switch (j.mode) {
    default: return j.col0 + n;
    case 1: { const int pn = n >> 8, half = (n >> 7) & 1, jj = n & 127; return half * 256 + pn * 128 + jj; }
    }
}
#define CONV_ISSUE(t_) do { const int b_ = (t_) / per, r_ = (t_) - b_ * per, nt_ = r_ / nkt, kt_ = r_ - nt_ * nkt; \
        const float* s_ = j.src + (size_t)b_ * j.sbatch + (size_t)(kt_ * 128) * j.ldn + conv_srccol(j, nt_); \
        const bool ok_ = nt_ * 64 + n4 < j.nvalid; \
        _Pragma("unroll") for (int i = 0; i < 2; ++i) _Pragma("unroll") for (int q = 0; q < 2; ++q) \
            v[i][q] = ok_ ? *(const f32x4*)(s_ + (size_t)(2 * kp + q + 64 * i) * j.ldn + n4) : (f32x4){0.f, 0.f, 0.f, 0.f}; } while (0)
DEV int conv_run(const ConvJob& j, int rot) {
    const Ctx c = make_ctx();
    LAS bf16_t* T = (LAS bf16_t*)c.lds;
    const int nkt = j.K >> 7, per = j.ntn * nkt, total = per * j.nbatch;
    const int n4 = (c.tid & 15) * 4, kp = c.tid >> 4;
    const int first = (c.vcu - (rot % c.G) + c.G) % c.G;
    f32x4 v[2][2];
    int par = 0;
    if (first < total) CONV_ISSUE(first);
    for (int t = first; t < total; t += c.G) {
        LAS bf16_t* Tb = T + par * (64 * 136);
#pragma unroll
        for (int i = 0; i < 2; ++i)
#pragma unroll
            for (int jj = 0; jj < 4; ++jj) *(LAS unsigned*)(Tb + (n4 + jj) * 136 + 2 * kp + 64 * i) = cvt_pk_bf16(v[i][0][jj], v[i][1][jj]);
        const int b = t / per, r = t - b * per, nt = r / nkt, kt = r - nt * nkt;
        if (t + c.G < total) CONV_ISSUE(t + c.G);
        __syncthreads();
#pragma unroll
        for (int q = 0; q < 2; ++q) {
            const int id = c.tid + 512 * q, n = id >> 4, cc = id & 15;
            const u32x4 o = *(const LAS u32x4*)(Tb + n * 136 + cc * 8);
            *(u32x4*)(j.dst + (size_t)b * j.dbatch + (size_t)(nt * 64 + n) * j.K + kt * 128 + cc * 8) = o;
        }
        par ^= 1;
    }
    __syncthreads();
    return rot + total;
}
DEV int conv(const float* src, int ldn, int col0, int nvalid, int nrows_pad, int K, bf16_t* dst, int rot) {
    ConvJob j; j.src = src; j.dst = dst; j.ldn = ldn; j.K = K; j.ntn = nrows_pad / 64; j.nvalid = nvalid; j.nbatch = 1; j.sbatch = 0; j.dbatch = 0; j.mode = 0; j.col0 = col0;
    return conv_run(j, rot);
}

DEV void conv_router(const float* rw, bf16_t* dst) {
    const Ctx c = make_ctx();
    for (int idx = c.vcu * NTHR + c.tid; idx < 64 * 1024; idx += c.G * NTHR) {
        const int k = idx >> 6, e = idx & 63;
        const int fq = e >> 4, q = e & 15, i = 16 * (q >> 2) + 4 * fq + (q & 3);
        dst[(size_t)i * 1024 + k] = f2bf(rw[idx]);
    }
}

DEV void sincos_d(double x, double& s, double& c) {
    const double k = rint(x * 0.6366197723675814);
    const double r = (x - k * 1.5707963267948966) - k * 6.123233995736766e-17;
    const double r2 = r * r;
    double sp = -7.647163731819816e-13; sp = sp * r2 + 1.605904383682161e-10; sp = sp * r2 - 2.505210838544172e-08; sp = sp * r2 + 2.755731922398589e-06;
    sp = sp * r2 - 1.984126984126984e-04; sp = sp * r2 + 8.333333333333333e-03; sp = sp * r2 - 1.666666666666667e-01; sp = r + r * r2 * sp;
    double cp = -1.147074559772972e-11; cp = cp * r2 + 2.087675698786810e-09; cp = cp * r2 - 2.755731922398589e-07; cp = cp * r2 + 2.480158730158730e-05;
    cp = cp * r2 - 1.388888888888889e-03; cp = cp * r2 + 4.166666666666666e-02; cp = cp * r2 - 0.5; cp = 1.0 + r2 * cp;
    const int q = ((int)k) & 3;
    s = (q == 0) ? sp : (q == 1) ? cp : (q == 2) ? -sp : -cp;
    c = (q == 0) ? cp : (q == 1) ? -sp : (q == 2) ? -cp : sp;
}
DEV void rope_table() {
    const Ctx c = make_ctx();
    float* ct = c.w<float>(WS_ROPE); float* st = ct + 4096 * 8;
    const float inv[8] = {1.0f, 0.19393656f, 0.037611387f, 0.0072942254f, 0.0014146171f, 0.00027434599f, 5.3205722e-05f, 1.0318535e-05f};
    for (int idx = c.vcu * NTHR + c.tid; idx < 4096 * 8; idx += c.G * NTHR) {
        const int pos = idx >> 3, i = idx & 7;
        float iv = inv[0];
#pragma unroll
        for (int q = 1; q < 8; ++q) iv = (i == q) ? inv[q] : iv;
        const float ang = (float)pos * iv;
        double s, co; sincos_d((double)ang, s, co);
        ct[idx] = (float)co; st[idx] = (float)s;
    }
}

DEV void prologue() {
    const Ctx c = make_ctx();
    const float* x = c.in(0);
    bf16_t* xb = c.w<bf16_t>(WS_XB);
    const size_t n4 = (size_t)NTOK * DM / 4;
    for (size_t i = (size_t)c.vcu * NTHR + c.tid; i < n4; i += (size_t)c.G * NTHR) {
        const f32x4 v = ((const f32x4*)x)[i];
        ((f32x4*)c.xf)[i] = v;
        u32x2 o; o.x = cvt_pk_bf16(v[0], v[1]); o.y = cvt_pk_bf16(v[2], v[3]);
        ((u32x2*)xb)[i] = o;
    }
    for (int i = c.vcu * NTHR + c.tid; i < 256 * DM / 2; i += c.G * NTHR) ((unsigned*)(xb + (size_t)NTOK * DM))[i] = 0u;
    rope_table();
}

template <int MODE>
DEV void ln_phase(const float* g, const float* b) {
    const Ctx c = make_ctx();
    bf16_t* xb = c.w<bf16_t>(WS_XB);
    const int* pos = c.w<int>(A_POS);
    const bf16_t* Y = c.w<bf16_t>(A_Y);
    f32x4 gv[4], bv[4];
#pragma unroll
    for (int j = 0; j < 4; ++j) { gv[j] = *(const f32x4*)(g + j * 256 + c.lane * 4); bv[j] = *(const f32x4*)(b + j * 256 + c.lane * 4); }
    for (int row = c.vcu * NWAVE + c.wave; row < NTOK; row += c.G * NWAVE) {
        float* xr = c.xf + (size_t)row * DM;
        f32x4 v[4];
#pragma unroll
        for (int j = 0; j < 4; ++j) v[j] = *(const f32x4*)(xr + j * 256 + c.lane * 4);
        if (MODE == 1) {
            int p[8];
#pragma unroll
            for (int k = 0; k < 8; ++k) p[k] = pos[row * 8 + k];
#pragma unroll
            for (int k = 0; k < 8; ++k) {
                const bf16_t* yr = Y + (size_t)p[k] * DM;
#pragma unroll
                for (int j = 0; j < 4; ++j) {
                    const u32x2 w = *(const u32x2*)(yr + j * 256 + c.lane * 4);
                    v[j][0] += bflo(w.x); v[j][1] += bfhi(w.x); v[j][2] += bflo(w.y); v[j][3] += bfhi(w.y);
                }
            }
        }
        float s = 0.f;
#pragma unroll
        for (int j = 0; j < 4; ++j) s += (v[j][0] + v[j][1]) + (v[j][2] + v[j][3]);
        const float mu = wave_sum(s, c.lane) * (1.f / 1024.f);
        float q = 0.f;
#pragma unroll
        for (int j = 0; j < 4; ++j) { v[j] = v[j] - mu; q += (v[j][0] * v[j][0] + v[j][1] * v[j][1]) + (v[j][2] * v[j][2] + v[j][3] * v[j][3]); }
        const float rs = __builtin_amdgcn_rsqf(wave_sum(q, c.lane) * (1.f / 1024.f) + LN_EPS);
#pragma unroll
        for (int j = 0; j < 4; ++j) {
            const f32x4 o = v[j] * rs * gv[j] + bv[j];
            *(f32x4*)(xr + j * 256 + c.lane * 4) = o;
            u32x2 w; w.x = cvt_pk_bf16(o[0], o[1]); w.y = cvt_pk_bf16(o[2], o[3]);
            *(u32x2*)(xb + (size_t)row * DM + j * 256 + c.lane * 4) = w;
        }
    }
}

constexpr int BM = 256, BK = 64, HALF = 128, HT = HALF * BK;

enum { EPI_NSA_A = 1, EPI_NSA_V, EPI_CMP1, EPI_WOUT, EPI_GLA_A, EPI_GLA_V, EPI_DIL_A, EPI_DIL_V, EPI_MOE1, EPI_MOE2 };
enum { AM_ID = 0, AM_IDX = 1, AM_CMP = 2 };
enum { BM_ID = 0, BM_DIL = 1, BM_EXP = 2 };

struct GemmDesc {
    const bf16_t* A; const bf16_t* Bt;
    int lda, ldb, K, kstepA;
    int nM, nN; const int* nM_ptr;
    int amode; const int* aidx;
    int bmode; const int* tile_e; size_t bstride;
    int epi;
    void* o0; void* o1; void* o2; void* o3;
    const float* f0; const float* f1;
};

#ifndef GEMM_LINKAGE
#define GEMM_LINKAGE __device__ __forceinline__
#endif
DEV GemmDesc load_desc(const Ctx& c, int slot) {
    const GemmDesc* s = (const GemmDesc*)(unsigned char*)(c.lds + LDS_DESC + slot * 192);
    GemmDesc d;
    d.A = unip(s->A); d.Bt = unip(s->Bt); d.lda = uni(s->lda); d.ldb = uni(s->ldb); d.K = uni(s->K); d.kstepA = uni(s->kstepA);
    d.nM = uni(s->nM); d.nN = uni(s->nN); d.nM_ptr = unip(s->nM_ptr); d.amode = uni(s->amode); d.aidx = unip(s->aidx);
    d.bmode = uni(s->bmode); d.tile_e = unip(s->tile_e); d.bstride = (size_t)uni64((unsigned long long)s->bstride); d.epi = uni(s->epi);
    d.o0 = unip(s->o0); d.o1 = unip(s->o1); d.o2 = unip(s->o2); d.o3 = unip(s->o3); d.f0 = unip(s->f0); d.f1 = unip(s->f1);
    return d;
}
DEV int lds_byte(int r, int c) { const int st = (r >> 4) * 2 + (c >> 5), rr = r & 15, cc = c & 31, ob = rr * 64 + cc * 2; return st * 1024 + (ob ^ (((ob >> 9) & 1) << 5)); }
DEV void stage_rc(int b, int& R, int& C) { const int st = b / 1024, sb = b % 1024, swz = sb ^ (((sb >> 9) & 1) << 5); R = (st >> 1) * 16 + swz / 64; C = (st & 1) * 32 + (swz % 64) / 2; }

DEV float rope_pair(float v, float partner, bool hi, float cs, float sn) {
    return hi ? (v * cs + partner * sn) : (v * cs - partner * sn);
}

DEV void stage_put(LAS unsigned char* lds, int lrow, int lcol, u32x2 w) {
    *(LAS u32x2*)(lds + lrow * 512 + (((lcol >> 3) ^ (lrow & 15)) << 4) + ((lcol & 4) << 1)) = w;
}
DEV u32x2 pk4(f32x4 v) { u32x2 w; w.x = cvt_pk_bf16(v[0], v[1]); w.y = cvt_pk_bf16(v[2], v[3]); return w; }
DEV int vt16_col(int lcol) { return (lcol & ~15) + 8 * ((lcol >> 2) & 1) + 4 * ((lcol >> 3) & 1); }

template <int EPI>
DEV void epi_quad(const Ctx& c, const GemmDesc& d, int row, int col, int lrow, int lcol, f32x4 v, int pm) {
    if (EPI == EPI_WOUT) {
        float* p = (float*)d.o0 + (size_t)row * DM + col;
        f32x4 x = *(f32x4*)p; x = x * DN_ALPHA + v; *(f32x4*)p = x;
    } else if (EPI == EPI_NSA_A) {
        const bool roped = (col < 1280) || (col >= 1536 && col < 2048);
        const int hd = col & 63;
        if (roped) {
            f32x4 pv; pv[0] = xor32_f(v[0], c.lane); pv[1] = xor32_f(v[1], c.lane); pv[2] = xor32_f(v[2], c.lane); pv[3] = xor32_f(v[3], c.lane);
            if (hd < 16) {
                const int pos = row & (SEQ - 1); const float* ct = c.w<float>(WS_ROPE) + pos * 8 + (hd & 7); const float* st = ct + 4096 * 8;
                const f32x4 cs = *(const f32x4*)ct, sn = *(const f32x4*)st; const bool hi = hd >= 8;
#pragma unroll
                for (int j = 0; j < 4; ++j) v[j] = rope_pair(v[j], pv[j], hi, cs[j], sn[j]);
            }
        }
        if (col < 1024) stage_put(c.lds, lrow, lcol, pk4(v * QSCALE));
        else if (col < 2048) stage_put(c.lds, lrow, lcol, pk4(v));
        else if (col < 2048 + 48) {
            f32x4 g; g[0] = sigmoidf_(v[0]); g[1] = sigmoidf_(v[1]); g[2] = sigmoidf_(v[2]); g[3] = sigmoidf_(v[3]);
            *(f32x4*)((float*)d.o2 + (size_t)row * 48 + (col - 2048)) = g;
        }
    } else if (EPI == EPI_NSA_V || EPI == EPI_DIL_V) {
        stage_put(c.lds, lrow, vt16_col(lcol), pk4(v));
    } else if (EPI == EPI_CMP1) {
        const int which = row >> 13; const f32x4 bb = *(const f32x4*)(d.f0 + which * 256 + col);
        v = v + bb; f32x4 g; g[0] = gelu_tanh(v[0]); g[1] = gelu_tanh(v[1]); g[2] = gelu_tanh(v[2]); g[3] = gelu_tanh(v[3]);
        stage_put(c.lds, lrow, lcol, pk4(g));
    } else if (EPI == EPI_GLA_A) {
        if (col < 1024) stage_put(c.lds, lrow, lcol, pk4(v));
        else if (col < 2048) { f32x4 g; g[0] = siluf_(v[0]); g[1] = siluf_(v[1]); g[2] = siluf_(v[2]); g[3] = siluf_(v[3]); stage_put(c.lds, lrow, lcol, pk4(g)); }
        else if (col < 2048 + 16) *(f32x4*)((float*)d.o2 + (size_t)row * 16 + (col - 2048)) = v;
    } else if (EPI == EPI_GLA_V) {
        stage_put(c.lds, lrow, lcol, pk4(v));
    } else if (EPI == EPI_DIL_A) {
        const int hd = col & 63;
        f32x4 pv; pv[0] = xor32_f(v[0], c.lane); pv[1] = xor32_f(v[1], c.lane); pv[2] = xor32_f(v[2], c.lane); pv[3] = xor32_f(v[3], c.lane);
        if (hd < 16) {
            const int pos = row & (SEQ - 1); const float* ct = c.w<float>(WS_ROPE) + pos * 8 + (hd & 7); const float* st = ct + 4096 * 8;
            const f32x4 cs = *(const f32x4*)ct, sn = *(const f32x4*)st; const bool hi = hd >= 8;
#pragma unroll
            for (int j = 0; j < 4; ++j) v[j] = rope_pair(v[j], pv[j], hi, cs[j], sn[j]);
        }
        if (((col >> 10) & 1) == 0) v = v * QSCALE;
        stage_put(c.lds, lrow, lcol, pk4(v));
    } else if (EPI == EPI_MOE2) {
        const int e = uni(d.tile_e[pm]);
        if (e == 64) {
            const int tok = ((const int*)d.o2)[row];
            float* p = (float*)d.o1 + (size_t)tok * DM + col;
            f32x4 x = *(f32x4*)p; x = x * DN_ALPHA + v; *(f32x4*)p = x;
        } else stage_put(c.lds, lrow, lcol, pk4(v * d.f0[row]));
    }
    (void)pm; (void)lrow; (void)lcol;
}

template <int EPI>
DEV bf16_t* epi_rowptr(const GemmDesc& d, int grow, int pn, int bcol, int pm) {
    if (EPI == EPI_NSA_A) { if (pn < 4) return (bf16_t*)d.o0 + (size_t)grow * 1024 + pn * 256; if (pn < 8) return (bf16_t*)d.o1 + (size_t)(pn - 4) * NTOK * 256 + (size_t)grow * 256; return nullptr; }
    if (EPI == EPI_NSA_V) { const int vb = grow >> 8, kvh = (grow >> 6) & 3, dd = grow & 63, b = bcol >> 12, s0 = bcol & 4095;
        return (bf16_t*)d.o0 + (size_t)vb * (8u * 4u * 64u * 4096u) + ((size_t)((b * 4 + kvh) * 64 + dd)) * 4096 + s0; }
    if (EPI == EPI_CMP1) return (bf16_t*)d.o0 + (size_t)grow * 256;
    if (EPI == EPI_GLA_A) { if (pn < 4) return (bf16_t*)d.o0 + (size_t)(pn >> 1) * NTOK * 512 + (size_t)grow * 512 + (pn & 1) * 256; if (pn < 8) return (bf16_t*)d.o1 + (size_t)grow * 1024 + (pn - 4) * 256; return nullptr; }
    if (EPI == EPI_GLA_V) { const int b = bcol >> 12, s0 = bcol & 4095; return (bf16_t*)d.o0 + ((size_t)(b * 1024 + grow)) * 4096 + s0; }
    if (EPI == EPI_DIL_A) { const int g = pn >> 3, qk = (pn >> 2) & 1; return (bf16_t*)(qk ? d.o1 : d.o0) + (size_t)g * NTOK * 1024 + (size_t)grow * 1024 + (pn & 3) * 256; }
    if (EPI == EPI_DIL_V) { const int g = grow >> 10, hh = (grow >> 6) & 15, dd = grow & 63, b = bcol >> 12, j0 = bcol & 4095;
        return (bf16_t*)d.o0 + ((size_t)(((g * 8 + b) * 16 + hh) * 64 + dd)) * 4096 + j0; }
    if (EPI == EPI_MOE1) return (bf16_t*)d.o0 + (size_t)grow * 256 + pn * 128;
    if (EPI == EPI_MOE2) { if (uni(d.tile_e[pm]) == 64) return nullptr; return (bf16_t*)d.o0 + (size_t)grow * 1024 + pn * 256; }
    return nullptr;
}
template <int EPI>
DEV void epi_writeout(const Ctx& c, const GemmDesc& d, int brow, int bcol, int pn, int pm) {
    constexpr int NCH = (EPI == EPI_MOE1) ? 16 : 32;
    __syncthreads();
    if (epi_rowptr<EPI>(d, brow, pn, bcol, pm) != nullptr) {
        const int q = c.tid & 31;
#pragma unroll 4
        for (int it = 0; it < 16; ++it) {
            const int lrow = it * 16 + (c.tid >> 5);
            if (q < NCH) {
                const u32x4 val = *(const LAS u32x4*)(c.lds + lrow * 512 + (q << 4));
                bf16_t* rp = epi_rowptr<EPI>(d, brow + lrow, pn, bcol, pm);
                *(u32x4*)(rp + ((q ^ (lrow & 15)) << 3)) = val;
            }
        }
    }
}

#define GSA(b, h) (((b) * 2 + (h)) * (HT * 2))
#define GSB(b, h) ((4 + (b) * 2 + (h)) * (HT * 2))
#define GLDS16(gp, lp) __builtin_amdgcn_global_load_lds((const unsigned*)(gp), (LAS unsigned*)(lp), 16, 0, 0)
#define STAGE(bufoff, g, voff) do { GLDS16((g) + (voff)[0], lds + (bufoff) + ldsw); GLDS16((g) + (voff)[1], lds + (bufoff) + ldsw + 8192); } while (0)
#define LDA(dst, b, h) _Pragma("unroll") for (int m = 0; m < 4; ++m) _Pragma("unroll") for (int k = 0; k < 2; ++k) \
    dst[m][k] = *(const LAS bf16x8*)(lds + GSA(b, h) + aoff + m * 2048 + k * 1024)
#define LDB(dst, b, h) _Pragma("unroll") for (int n = 0; n < 2; ++n) _Pragma("unroll") for (int k = 0; k < 2; ++k) \
    dst[n][k] = *(const LAS bf16x8*)(lds + GSB(b, h) + boff + n * 2048 + k * 1024)
#define MMA(ai, bj, At_, Bt_) do { __builtin_amdgcn_s_setprio(1); \
    _Pragma("unroll") for (int m = 0; m < 4; ++m) _Pragma("unroll") for (int n = 0; n < 2; ++n) _Pragma("unroll") for (int k = 0; k < 2; ++k) \
        acc[ai][bj][m][n] = __builtin_amdgcn_mfma_f32_16x16x32_bf16(Bt_[n][k], At_[m][k], acc[ai][bj][m][n], 0, 0, 0); \
    __builtin_amdgcn_s_setprio(0); } while (0)
#define WAIT_V(n) asm volatile("s_waitcnt vmcnt(" #n ")" ::: "memory")
#define WAIT_L(n) asm volatile("s_waitcnt lgkmcnt(" #n ")" ::: "memory")
#define BAR __builtin_amdgcn_s_barrier()
#define SCHED __builtin_amdgcn_sched_barrier(0)
#define EPI_LOOP(E) _Pragma("unroll") for (int ai = 0; ai < 2; ++ai) _Pragma("unroll") for (int bj = 0; bj < 2; ++bj) \
    _Pragma("unroll") for (int m = 0; m < 4; ++m) _Pragma("unroll") for (int n = 0; n < 2; ++n) \
        epi_quad<E>(c, d, brow + ai * HALF + wr * 64 + m * 16 + fr, bcol + bj * HALF + wc * 32 + n * 16 + fq * 4, ai * HALF + wr * 64 + m * 16 + fr, bj * HALF + wc * 32 + n * 16 + fq * 4, acc[ai][bj][m][n], pm)

GEMM_LINKAGE void gemm_phase(int slot) {
    const Ctx c = make_ctx();
    const GemmDesc d = load_desc(c, slot);
    LAS unsigned char* lds = c.lds;
    const int nM = d.nM_ptr ? uni(*d.nM_ptr) : d.nM;
    const int nN = d.nN, U = nM * nN, nt = d.K / BK;
    const size_t kstA = (size_t)d.kstepA * 2, kstB = (size_t)BK * 2;
    for (int u = c.vcu; u < U; u += c.G) {
        const int pm = u / nN, pn = u - pm * nN, brow = pm * BM, bcol = pn * BM;
        int tz = threadIdx.x; asm volatile("" : "+v"(tz));
        const int wid = uni(tz >> 6), wr = wid >> 2, wc = wid & 3;
        const unsigned ldsw = (unsigned)wid * 1024u;
        const char* cA0; const char* cA1; const char* cB0; const char* cB1;
        unsigned voffA0[2], voffA1[2], voffB[2];
        {
            const char* Bb = (const char*)d.Bt;
            if (d.bmode == BM_EXP) Bb += (size_t)uni(d.tile_e[pm]) * d.bstride * 2;
            int sh = 0;
            if (d.bmode == BM_DIL) { sh = 2 * (pm >> 2); cB0 = Bb + (size_t)(bcol & ~4095) * d.ldb * 2; cB1 = cB0 + ((size_t)(128 << sh) * d.ldb) * 2; }
            else { cB0 = Bb + (size_t)bcol * d.ldb * 2; cB1 = cB0 + (size_t)HALF * d.ldb * 2; }
            if (d.amode == AM_CMP) { const int which = brow >> 13, bk = (brow & 8191) >> 8;
                cA0 = (const char*)d.A + ((size_t)which * (NTOK * 256) + (size_t)((bk >> 2) * SEQ) * 256 + (bk & 3) * 64) * 2; cA1 = cA0 + (size_t)HALF * d.lda * 2; }
            else if (d.amode == AM_IDX) { cA0 = (const char*)d.A; cA1 = cA0; }
            else { cA0 = (const char*)d.A + (size_t)brow * d.lda * 2; cA1 = cA0 + (size_t)HALF * d.lda * 2; }
#pragma unroll
            for (int i = 0; i < 2; ++i) {
                int R, C; stage_rc(tz * 16 + i * 8192, R, C);
                if (d.amode == AM_IDX) { voffA0[i] = (unsigned)(d.aidx[brow + R] * d.lda + C) * 2u; voffA1[i] = (unsigned)(d.aidx[brow + HALF + R] * d.lda + C) * 2u; }
                else { voffA0[i] = (unsigned)(R * d.lda + C) * 2u; voffA1[i] = voffA0[i]; }
                if (d.bmode == BM_DIL) { const int jx = (bcol & 4095) + R, rr = jx >> (12 - sh), uu = jx & ((4096 >> sh) - 1); voffB[i] = (unsigned)(((uu << sh) | rr) * d.ldb + C) * 2u; }
                else voffB[i] = (unsigned)(R * d.ldb + C) * 2u;
            }
        }
        asm volatile("s_waitcnt vmcnt(0)" ::: "memory");
        f32x4 acc[2][2][4][2];
#pragma unroll
        for (int ai = 0; ai < 2; ++ai)
#pragma unroll
            for (int bj = 0; bj < 2; ++bj)
#pragma unroll
                for (int m = 0; m < 4; ++m)
#pragma unroll
                    for (int n = 0; n < 2; ++n) acc[ai][bj][m][n] = (f32x4){0.f, 0.f, 0.f, 0.f};
        bf16x8 At[4][2], B0[2][2], B1[2][2];
        {
        const int lane = tz & 63, fr = lane & 15, fq = lane >> 4;
        const int aoff = lds_byte(wr * 64 + fr, fq * 8), boff = lds_byte(wc * 32 + fr, fq * 8);
        STAGE(GSB(0, 0), cB0, voffB); STAGE(GSA(0, 0), cA0, voffA0);
        STAGE(GSB(0, 1), cB1, voffB); STAGE(GSA(0, 1), cA1, voffA1);
        if (wr == 1) BAR;
        WAIT_V(4); BAR;
        STAGE(GSB(1, 0), cB0 + kstB, voffB); STAGE(GSA(1, 0), cA0 + kstA, voffA0); STAGE(GSB(1, 1), cB1 + kstB, voffB);
        WAIT_V(6); BAR;
        for (int t = 0; t < nt - 2; t += 2) {
            const char* a1 = cA1 + (size_t)(t + 1) * kstA;
            const char* a20 = cA0 + (size_t)(t + 2) * kstA; const char* a21 = cA1 + (size_t)(t + 2) * kstA;
            const char* b20 = cB0 + (size_t)(t + 2) * kstB; const char* b21 = cB1 + (size_t)(t + 2) * kstB;
            LDB(B0, 0, 0); SCHED; LDA(At, 0, 0); STAGE(GSA(1, 1), a1, voffA1);
            WAIT_L(8); BAR; WAIT_L(0); MMA(0, 0, At, B0); BAR; SCHED;
            LDB(B1, 0, 1); STAGE(GSB(0, 0), b20, voffB);
            BAR; WAIT_L(0); MMA(0, 1, At, B1); BAR;
            LDA(At, 0, 1); STAGE(GSA(0, 0), a20, voffA0);
            BAR; WAIT_L(0); MMA(1, 0, At, B0); BAR; SCHED;
            STAGE(GSB(0, 1), b21, voffB);
            WAIT_V(6); BAR; MMA(1, 1, At, B1); BAR;
            LDB(B0, 1, 0); SCHED; LDA(At, 1, 0); STAGE(GSA(0, 1), a21, voffA1);
            WAIT_L(8); BAR; WAIT_L(0); MMA(0, 0, At, B0); BAR; SCHED;
            LDB(B1, 1, 1); STAGE(GSB(1, 0), b20 + kstB, voffB);
            BAR; WAIT_L(0); MMA(0, 1, At, B1); BAR;
            LDA(At, 1, 1); STAGE(GSA(1, 0), a20 + kstA, voffA0);
            BAR; WAIT_L(0); MMA(1, 0, At, B0); BAR; SCHED;
            STAGE(GSB(1, 1), b21 + kstB, voffB);
            WAIT_V(6); BAR; MMA(1, 1, At, B1); BAR;
        }
        { LDB(B0, 0, 0); WAIT_V(0); LDA(At, 0, 0); STAGE(GSA(1, 1), cA1 + (size_t)(nt - 1) * kstA, voffA1);
          BAR; WAIT_L(0); MMA(0, 0, At, B0); BAR;
          LDB(B1, 0, 1); BAR; WAIT_L(0); MMA(0, 1, At, B1); BAR;
          LDA(At, 0, 1); WAIT_V(4); BAR; WAIT_L(0); MMA(1, 0, At, B0); MMA(1, 1, At, B1); BAR; }
        { LDB(B0, 1, 0); LDA(At, 1, 0); WAIT_V(2); BAR; WAIT_L(0); MMA(0, 0, At, B0); BAR;
          LDB(B1, 1, 1); WAIT_V(0); BAR; WAIT_L(0); MMA(0, 1, At, B1); BAR;
          LDA(At, 1, 1); BAR; WAIT_L(0); MMA(1, 0, At, B0); MMA(1, 1, At, B1); BAR; }
        if (wr == 0) BAR;
        }
        int ty = threadIdx.x; asm volatile("" : "+v"(ty));
        const int lane = ty & 63, fr = lane & 15, fq = lane >> 4;
        __syncthreads();
        switch (d.epi) {
        case EPI_WOUT:  EPI_LOOP(EPI_WOUT); break;
        case EPI_NSA_A: EPI_LOOP(EPI_NSA_A); epi_writeout<EPI_NSA_A>(c, d, brow, bcol, pn, pm); break;
        case EPI_NSA_V: EPI_LOOP(EPI_NSA_V); epi_writeout<EPI_NSA_V>(c, d, brow, bcol, pn, pm); break;
        case EPI_CMP1:  EPI_LOOP(EPI_CMP1); epi_writeout<EPI_CMP1>(c, d, brow, bcol, pn, pm); break;
        case EPI_GLA_A: EPI_LOOP(EPI_GLA_A); epi_writeout<EPI_GLA_A>(c, d, brow, bcol, pn, pm); break;
        case EPI_GLA_V: EPI_LOOP(EPI_GLA_V); epi_writeout<EPI_GLA_V>(c, d, brow, bcol, pn, pm); break;
        case EPI_DIL_A: EPI_LOOP(EPI_DIL_A); epi_writeout<EPI_DIL_A>(c, d, brow, bcol, pn, pm); break;
        case EPI_DIL_V: EPI_LOOP(EPI_DIL_V); epi_writeout<EPI_DIL_V>(c, d, brow, bcol, pn, pm); break;
        case EPI_MOE2:  EPI_LOOP(EPI_MOE2); epi_writeout<EPI_MOE2>(c, d, brow, bcol, pn, pm); break;
        case EPI_MOE1: {
#pragma unroll
            for (int ai = 0; ai < 2; ++ai)
#pragma unroll
                for (int m = 0; m < 4; ++m)
#pragma unroll
                    for (int n = 0; n < 2; ++n) {
                        const f32x4 g = acc[ai][0][m][n], uu = acc[ai][1][m][n];
                        u32x2 w; w.x = cvt_pk_bf16(siluf_(g[0]) * uu[0], siluf_(g[1]) * uu[1]); w.y = cvt_pk_bf16(siluf_(g[2]) * uu[2], siluf_(g[3]) * uu[3]);
                        stage_put(c.lds, ai * HALF + wr * 64 + m * 16 + fr, wc * 32 + n * 16 + fq * 4, w);
                    }
            epi_writeout<EPI_MOE1>(c, d, brow, bcol, pn, pm);
        } break;
        default: break;
        }
        asm volatile("s_waitcnt vmcnt(0)" ::: "memory");
        __syncthreads();
    }
}

DEV void route_a(const float* rb) {
    const Ctx c = make_ctx();
    const bf16_t* xb = c.w<bf16_t>(WS_XB);
    const bf16_t* rwt = c.w<bf16_t>(WS_WR);
    int* PE = c.w<int>(A_PE); float* PG = c.w<float>(A_PG); int* PR = c.w<int>(A_PR);
    int* CNT = c.w<int>(WS_META) + META_CNT;
    LAS int* el = (LAS int*)c.lds;
    LAS int* lr = el + 1024;
    const int fr = c.lane & 15, fq = c.lane >> 4;
    for (int unit = c.vcu; unit < NTOK / 128; unit += c.G) {
        const int tok0 = unit * 128 + c.wave * 16;
        f32x4 acc[4];
#pragma unroll
        for (int nt = 0; nt < 4; ++nt) acc[nt] = (f32x4){0.f, 0.f, 0.f, 0.f};
        const bf16_t* xr = xb + (size_t)(tok0 + fr) * DM + fq * 8;
        const bf16_t* wr_ = rwt + (size_t)fr * DM + fq * 8;
#pragma unroll 4
        for (int ks = 0; ks < 32; ++ks) {
            const bf16x8 bx = *(const bf16x8*)(xr + ks * 32);
#pragma unroll
            for (int nt = 0; nt < 4; ++nt) {
                const bf16x8 aw = *(const bf16x8*)(wr_ + (size_t)nt * 16 * DM + ks * 32);
                acc[nt] = __builtin_amdgcn_mfma_f32_16x16x32_bf16(aw, bx, acc[nt], 0, 0, 0);
            }
        }
        float s[16], sb[16];
#pragma unroll
        for (int q = 0; q < 16; ++q) { s[q] = sigmoidf_(acc[q >> 2][q & 3]); sb[q] = s[q] + rb[16 * fq + q]; }
        float gs[2];
#pragma unroll
        for (int hh = 0; hh < 2; ++hh) {
            float m1 = -3.0e38f, m2 = -3.0e38f;
#pragma unroll
            for (int q = 0; q < 8; ++q) { const float v = sb[8 * hh + q]; const bool gt = v > m1; m2 = gt ? m1 : fmaxf(m2, v); m1 = gt ? v : m1; }
            gs[hh] = m1 + m2;
        }
        float ga[8];
#pragma unroll
        for (int f2 = 0; f2 < 4; ++f2) { ga[2 * f2] = bperm_f(fr + 16 * f2, gs[0]); ga[2 * f2 + 1] = bperm_f(fr + 16 * f2, gs[1]); }
        bool gsel[2];
#pragma unroll
        for (int hh = 0; hh < 2; ++hh) {
            const int gi = 2 * fq + hh; const float mine = gs[hh]; int cnt = 0;
#pragma unroll
            for (int gj = 0; gj < 8; ++gj) cnt += (ga[gj] > mine || (ga[gj] == mine && gj < gi)) ? 1 : 0;
            gsel[hh] = cnt < 4;
        }
        float val[16];
#pragma unroll
        for (int q = 0; q < 16; ++q) val[q] = gsel[q >> 3] ? sb[q] : -3.0e38f;
        int ek[8]; float sk[8]; float ssum = 0.f;
#pragma unroll
        for (int k = 0; k < 8; ++k) {
            float bv = val[0], bs = s[0]; int bq = 0;
#pragma unroll
            for (int q = 1; q < 16; ++q) { const bool gt = val[q] > bv; bv = gt ? val[q] : bv; bs = gt ? s[q] : bs; bq = gt ? q : bq; }
            int be = 16 * fq + bq;
#pragma unroll
            for (int o = 16; o <= 32; o <<= 1) {
                const float ov = bperm_f(c.lane ^ o, bv), os = bperm_f(c.lane ^ o, bs); const int oe = bperm_i(c.lane ^ o, be);
                const bool take = (ov > bv) || (ov == bv && oe < be);
                bv = take ? ov : bv; bs = take ? os : bs; be = take ? oe : be;
            }
            ek[k] = be; sk[k] = bs; ssum += bs;
            const bool mine = (be >> 4) == fq; const int mq = be & 15;
#pragma unroll
            for (int q = 0; q < 16; ++q) val[q] = (mine && q == mq) ? -3.3e38f : val[q];
        }
        const float gsc = 2.5f / ssum;
        if (fq == 0) {
            const int tl = c.wave * 16 + fr, tg = tok0 + fr;
#pragma unroll
            for (int k = 0; k < 8; ++k) { el[tl * 8 + k] = ek[k]; PE[tg * 8 + k] = ek[k]; PG[tg * 8 + k] = sk[k] * gsc; }
        }
        __syncthreads();
        {
            LAS int* wc = lr + 1024;
            int cnt = 0;
            for (int p = c.wave * 128; p < c.wave * 128 + 128; ++p) { const int e = el[p]; if (e == c.lane) { lr[p] = cnt; ++cnt; } }
            wc[c.wave * 64 + c.lane] = cnt;
            __syncthreads();
            for (int p = c.tid; p < 1024; p += NTHR) { const int e = el[p], w = p >> 7; int off = 0; for (int q = 0; q < w; ++q) off += wc[q * 64 + e]; lr[p] += off; }
            if (c.tid < 64) { int t = 0; for (int q = 0; q < 8; ++q) t += wc[q * 64 + c.tid]; CNT[unit * 64 + c.tid] = t; }
        }
        __syncthreads();
        PR[unit * 1024 + c.tid] = lr[c.tid]; PR[unit * 1024 + 512 + c.tid] = lr[512 + c.tid];
        __syncthreads();
    }
}

DEV void route_b() {
    const Ctx c = make_ctx();
    const int* PE = c.w<int>(A_PE); const float* PG = c.w<float>(A_PG); const int* PR = c.w<int>(A_PR);
    int* POS = c.w<int>(A_POS); int* ROWTOK = c.w<int>(A_ROWTOK); float* ROWGATE = c.w<float>(A_ROWGATE);
    int* meta = c.w<int>(WS_META); const int* CNT = meta + META_CNT;
    LAS int* tot = (LAS int*)c.lds; LAS int* bef = tot + 64; LAS int* seg = bef + 64;
    const int nunit = NTOK / 128;
    for (int unit = c.vcu; unit < nunit; unit += c.G) {
        if (c.tid < 64) {
            int t = 0, b = 0;
            for (int u2 = 0; u2 < nunit; ++u2) { const int v = CNT[u2 * 64 + c.tid]; b += (u2 < unit) ? v : 0; t += v; }
            tot[c.tid] = t; bef[c.tid] = b;
        }
        __syncthreads();
        if (c.tid == 0) { int sg = 0; for (int e = 0; e < 64; ++e) { seg[e] = sg; sg += (tot[e] + 255) & ~255; } seg[64] = sg; }
        __syncthreads();
        const int P0 = seg[64];
        for (int p = c.tid; p < 1024; p += NTHR) {
            const int tok = unit * 128 + (p >> 3), gi = tok * 8 + (p & 7);
            const int e = PE[gi], dest = seg[e] + bef[e] + PR[unit * 1024 + p];
            POS[gi] = dest; ROWTOK[dest] = tok; ROWGATE[dest] = PG[gi];
        }
        if (unit < 64) {
            const int e = unit, lo = seg[e] + tot[e], hi = seg[e + 1];
            for (int r = lo + c.tid; r < hi; r += NTHR) { ROWTOK[r] = NTOK; ROWGATE[r] = 0.f; }
        }
        if (c.tid < 128) { const int r = P0 + unit * 128 + c.tid; ROWTOK[r] = unit * 128 + c.tid; ROWGATE[r] = 1.f; }
        if (unit == 0) {
            if (c.tid < 64) { for (int mt = seg[c.tid] >> 8; mt < (seg[c.tid + 1] >> 8); ++mt) meta[META_TILE + mt] = c.tid; }
            if (c.tid < 128) meta[META_TILE + (P0 >> 8) + c.tid] = 64;
            if (c.tid == 0) meta[META_NMT] = (P0 >> 8) + NTOK / 256;
        }
        __syncthreads();
    }
}

#define NEG_INF_F (-__builtin_inff())
struct FlashState { f32x16 o0, o1; float m, l; };
DEV void flash_init(FlashState& st) {
#pragma unroll
    for (int i = 0; i < 16; ++i) { st.o0[i] = 0.f; st.o1[i] = 0.f; }
    st.m = NEG_INF_F; st.l = 0.f;
}
DEV bf16x8 pack8(const f32x16& p, int base) {
    u32x4 w; w.x = cvt_pk_bf16(p[base + 0], p[base + 1]); w.y = cvt_pk_bf16(p[base + 2], p[base + 3]);
    w.z = cvt_pk_bf16(p[base + 4], p[base + 5]); w.w = cvt_pk_bf16(p[base + 6], p[base + 7]);
    return __builtin_bit_cast(bf16x8, w);
}
DEV f32x16 qk_tile(const bf16x8 (&kf)[4], const bf16x8 (&qf)[4]) {
    f32x16 S;
#pragma unroll
    for (int i = 0; i < 16; ++i) S[i] = 0.f;
#pragma unroll
    for (int s = 0; s < 4; ++s) S = __builtin_amdgcn_mfma_f32_32x32x16_bf16(kf[s], qf[s], S, 0, 0, 0);
    return S;
}
DEV void flash_tile(FlashState& st, f32x16 S, const bf16x8 (&vf)[4], bool need_mask, unsigned vmask, int lane) {
    if (need_mask) {
#pragma unroll
        for (int i = 0; i < 16; ++i) S[i] = ((vmask >> i) & 1u) ? S[i] : NEG_INF_F;
    }
    float mx = S[0];
#pragma unroll
    for (int i = 1; i < 16; ++i) mx = fmaxf(mx, S[i]);
    mx = fmaxf(mx, xor32_f(mx, lane));
    const float mn = fmaxf(st.m, mx);
    const float mu = (mn == NEG_INF_F) ? 0.f : mn;
    const float alpha = fast_exp2(st.m - mu);
    float ls = 0.f;
#pragma unroll
    for (int i = 0; i < 16; ++i) { S[i] = fast_exp2(S[i] - mu); ls += S[i]; }
    st.l = st.l * alpha + ls; st.m = mn;
    if (__builtin_amdgcn_ballot_w64(alpha != 1.f) != 0ull) {
#pragma unroll
        for (int i = 0; i < 16; ++i) { st.o0[i] *= alpha; st.o1[i] *= alpha; }
    }
    const bf16x8 p0 = pack8(S, 0), p1 = pack8(S, 8);
    st.o0 = __builtin_amdgcn_mfma_f32_32x32x16_bf16(vf[0], p0, st.o0, 0, 0, 0);
    st.o0 = __builtin_amdgcn_mfma_f32_32x32x16_bf16(vf[1], p1, st.o0, 0, 0, 0);
    st.o1 = __builtin_amdgcn_mfma_f32_32x32x16_bf16(vf[2], p0, st.o1, 0, 0, 0);
    st.o1 = __builtin_amdgcn_mfma_f32_32x32x16_bf16(vf[3], p1, st.o1, 0, 0, 0);
}
DEV int key_of(int key0, int i, int h) { return key0 + (i & 3) + 8 * (i >> 2) + 4 * h; }

template <class P>
DEV void flash_load(const P& pol, int tile, int r, int h, bf16x8 (&kf)[4], bf16x8 (&vf)[4]) {
    const bf16_t* kp = pol.kptr(tile * 32 + r) + 8 * h;
#pragma unroll
    for (int s = 0; s < 4; ++s) kf[s] = *(const bf16x8*)(kp + 16 * s);
    const bf16_t* v0 = pol.vptr(r) + tile * 32 + 8 * h;
    const bf16_t* v1 = pol.vptr(32 + r) + tile * 32 + 8 * h;
    vf[0] = *(const bf16x8*)(v0); vf[1] = *(const bf16x8*)(v0 + 16); vf[2] = *(const bf16x8*)(v1); vf[3] = *(const bf16x8*)(v1 + 16);
}
template <class P>
DEV void flash_run(const P& pol, const bf16x8 (&qf)[4], FlashState& st, int t0, int t1, int r, int h) {
    int t = t0;
    while (t < t1 && pol.skip(t)) ++t;
    if (t >= t1) return;
    bf16x8 kc[4], vc[4], kn[4], vn[4];
    flash_load(pol, t, r, h, kc, vc);
    while (t < t1) {
        int tn = t + 1;
        while (tn < t1 && pol.skip(tn)) ++tn;
        if (tn < t1) flash_load(pol, tn, r, h, kn, vn);
        const f32x16 S = qk_tile(kc, qf);
        const bool nm = pol.need_mask(t);
        flash_tile(st, S, vc, nm, nm ? pol.vmask(t * 32) : 0u, 32 * h + r);
#pragma unroll
        for (int s = 0; s < 4; ++s) { kc[s] = kn[s]; vc[s] = vn[s]; }
        t = tn;
    }
}
template <bool FIRST>
DEV void flash_accum(const FlashState& st, float gate, LAS float* ot, int lane) {
    const float lt = st.l + xor32_f(st.l, lane);
    const float sc = lt > 0.f ? gate * fast_rcp(lt) : 0.f;
#pragma unroll
    for (int i = 0; i < 16; ++i) {
        if (FIRST) { ot[i * 64 + lane] = st.o0[i] * sc; ot[(16 + i) * 64 + lane] = st.o1[i] * sc; }
        else { ot[i * 64 + lane] += st.o0[i] * sc; ot[(16 + i) * 64 + lane] += st.o1[i] * sc; }
    }
}
DEV void store_o(bf16_t* dst, const f32x16& t0, const f32x16& t1, int h) {
#pragma unroll
    for (int a = 0; a < 4; ++a) {
        u32x2 w; w.x = cvt_pk_bf16(t0[4 * a], t0[4 * a + 1]); w.y = cvt_pk_bf16(t0[4 * a + 2], t0[4 * a + 3]);
        *(u32x2*)(dst + 8 * a + 4 * h) = w;
        u32x2 x; x.x = cvt_pk_bf16(t1[4 * a], t1[4 * a + 1]); x.y = cvt_pk_bf16(t1[4 * a + 2], t1[4 * a + 3]);
        *(u32x2*)(dst + 32 + 8 * a + 4 * h) = x;
    }
}

struct PolCmp {
    const bf16_t* kb; const bf16_t* vb; int t, t0, h;
    DEV const bf16_t* kptr(int key) const { return kb + (size_t)min(key, 255) * 64; }
    DEV const bf16_t* vptr(int d) const { return vb + (size_t)d * 256; }
    DEV bool skip(int) const { return false; }
    DEV bool need_mask(int tile) const { return 16 * (tile * 32 + 31) + 31 > t0; }
    DEV unsigned vmask(int key0) const { unsigned m = 0;
#pragma unroll
        for (int i = 0; i < 16; ++i) m |= (16 * key_of(key0, i, h) + 31 <= t) ? (1u << i) : 0u;
        return m; }
};
struct PolSel {
    const bf16_t* kb; const bf16_t* vb; int t, t0, h; unsigned mlo, mhi;
    DEV bool selb(int tile) const { const int blk = tile >> 1; return ((blk < 32 ? (mlo >> blk) : (mhi >> (blk - 32))) & 1u) != 0u; }
    DEV const bf16_t* kptr(int key) const { return kb + (size_t)key * 256; }
    DEV const bf16_t* vptr(int d) const { return vb + (size_t)d * 4096; }
    DEV bool skip(int tile) const { return __builtin_amdgcn_ballot_w64(selb(tile)) == 0ull; }
    DEV bool need_mask(int tile) const { return (tile * 32 + 31 > t0) || (__builtin_amdgcn_ballot_w64(!selb(tile)) != 0ull); }
    DEV unsigned vmask(int key0) const { if (!selb(key0 >> 5)) return 0u; unsigned m = 0;
#pragma unroll
        for (int i = 0; i < 16; ++i) m |= (key_of(key0, i, h) <= t) ? (1u << i) : 0u;
        return m; }
};
struct PolWin {
    const bf16_t* kb; const bf16_t* vb; int t, t0, h;
    DEV const bf16_t* kptr(int key) const { return kb + (size_t)key * 256; }
    DEV const bf16_t* vptr(int d) const { return vb + (size_t)d * 4096; }
    DEV bool skip(int) const { return false; }
    DEV bool need_mask(int tile) const { return (tile * 32 + 31 > t0) || (tile * 32 < t0 + 7 - 511); }
    DEV unsigned vmask(int key0) const { unsigned m = 0;
#pragma unroll
        for (int i = 0; i < 16; ++i) { const int dd = t - key_of(key0, i, h); m |= (dd >= 0 && dd < 512) ? (1u << i) : 0u; }
        return m; }
};

constexpr int NSA_RING = 0, NSA_STAGE = 8192, NSA_IMP = 32768, NSA_OT = 65536, NSA_WGM = LDS_MISC + 704;
struct NsaSrc { const bf16_t* kb; const bf16_t* vb; int kstride, vstride; };
DEV void nsa_dma(const Ctx& c, const NsaSrc& s, int stage, int tile) {
    const bf16_t* src;
    if (c.wave < 4) { const int i = c.tid, r = i >> 3, cch = (i & 7) ^ (r & 7); src = s.kb + (size_t)(tile * 32 + r) * s.kstride + cch * 8; }
    else { const int i = c.tid - 256, dd = i >> 2, cch = (i & 3) ^ ((dd >> 2) & 3); src = s.vb + (size_t)dd * s.vstride + tile * 32 + cch * 8; }
    __builtin_amdgcn_global_load_lds((const unsigned*)src, (LAS unsigned*)(c.lds + NSA_RING + stage * NSA_STAGE + c.wave * 1024), 16, 0, 0);
}
DEV void nsa_frag(const Ctx& c, int stage, int r, int h, bf16x8 (&kf)[4], bf16x8 (&vf)[4]) {
    const LAS unsigned char* base = c.lds + NSA_RING + stage * NSA_STAGE;
#pragma unroll
    for (int s = 0; s < 4; ++s) kf[s] = *(const LAS bf16x8*)(base + r * 128 + (((2 * s + h) ^ (r & 7)) << 4));
    const int sw = (r >> 2) & 3;
    vf[0] = *(const LAS bf16x8*)(base + 4096 + r * 64 + (((0 + h) ^ sw) << 4));
    vf[1] = *(const LAS bf16x8*)(base + 4096 + r * 64 + (((2 + h) ^ sw) << 4));
    vf[2] = *(const LAS bf16x8*)(base + 4096 + (32 + r) * 64 + (((0 + h) ^ sw) << 4));
    vf[3] = *(const LAS bf16x8*)(base + 4096 + (32 + r) * 64 + (((2 + h) ^ sw) << 4));
}
#define NSA_WAITV(n) asm volatile("s_waitcnt vmcnt(" #n ")" ::: "memory")
#define NSA_STREAM(SRC, T0, T1, TAKE, BODY) do { \
    int tis_ = (T0); while (tis_ < (T1) && !(TAKE(tis_))) ++tis_; \
    int tu_ = tis_, infl_ = 0, si_ = 0, su_ = 0; \
    while (infl_ < 3 && tis_ < (T1)) { nsa_dma(c, SRC, si_, tis_); si_ = (si_ + 1) & 3; ++infl_; ++tis_; while (tis_ < (T1) && !(TAKE(tis_))) ++tis_; } \
    while (tu_ < (T1)) { \
        if (infl_ >= 3) NSA_WAITV(2); else if (infl_ == 2) NSA_WAITV(1); else NSA_WAITV(0); \
        __builtin_amdgcn_s_barrier(); \
        if (tis_ < (T1)) { nsa_dma(c, SRC, si_, tis_); si_ = (si_ + 1) & 3; ++infl_; ++tis_; while (tis_ < (T1) && !(TAKE(tis_))) ++tis_; } \
        BODY(tu_, su_); \
        su_ = (su_ + 1) & 3; --infl_; ++tu_; while (tu_ < (T1) && !(TAKE(tu_))) ++tu_; \
    } \
    __builtin_amdgcn_s_barrier(); } while (0)

DEV void nsa_unit(const Ctx& c, int b, int kvh, int P) {
    const int r = c.lane & 31, h = c.lane >> 5, ql = r >> 2, g = r & 3, w = c.wave;
    const int t0 = P * 64 + w * 8, t = t0 + ql, head = kvh * 4 + g, gtok = b * SEQ + t, bk = b * 4 + kvh;
    LAS float* lds_w = (LAS float*)(c.lds + NSA_IMP + w * 4096);
    LAS float* ot = (LAS float*)(c.lds + NSA_OT + w * 8192);
    const bf16_t* Q = c.w<bf16_t>(N_Q);
    bf16x8 qf[4];
#pragma unroll
    for (int s = 0; s < 4; ++s) qf[s] = *(const bf16x8*)(Q + (size_t)gtok * 1024 + head * 64 + 16 * s + 8 * h);
    const float* gt = c.w<float>(N_GATE) + (size_t)gtok * 48 + head * 3;
    const float g0 = gt[0], g1 = gt[1], g2 = gt[2];
    asm volatile("s_waitcnt vmcnt(0)" ::: "memory");
    const int cur = P;
    unsigned mlo, mhi, wlo, whi;
#define TAKE_ALL(t_) true
    {
        NsaSrc sc_; sc_.kb = c.w<bf16_t>(N_KCMP) + (size_t)bk * 256 * 64; sc_.vb = c.w<bf16_t>(N_VCMPT) + (size_t)bk * 64 * 256; sc_.kstride = 64; sc_.vstride = 256;
        PolCmp pc; pc.kb = sc_.kb; pc.vb = sc_.vb; pc.t = t; pc.t0 = t0; pc.h = h;
        const int ntcW = (4 * P + 3 + 31) >> 5;
        const int tmax = t0 + 7, ncmp = tmax >= 31 ? ((tmax - 31) >> 4) + 1 : 0, ntc = (ncmp + 31) >> 5;
        FlashState sc; flash_init(sc);
#define BODY_CMP(t_, st_) do { if ((t_) < ntc) { bf16x8 kf[4], vf[4]; nsa_frag(c, st_, r, h, kf, vf); const f32x16 S = qk_tile(kf, qf); \
            const bool nm = pc.need_mask(t_); flash_tile(sc, S, vf, nm, nm ? pc.vmask((t_) * 32) : 0u, c.lane); } } while (0)
        NSA_STREAM(sc_, 0, ntcW, TAKE_ALL, BODY_CMP);
        flash_accum<true>(sc, g0, ot, c.lane);
        if (cur < 16) { const unsigned long long mm = (1ull << (cur + 1)) - 1ull; mlo = (unsigned)mm; mhi = (unsigned)(mm >> 32); wlo = mlo; whi = mhi; }
        else {
            LAS float* GL = lds_w; LAS float* LL = lds_w + 512;
#pragma unroll
            for (int i = 0; i < 16; ++i) lds_w[c.lane + 64 * i] = 0.f;
            const float lt = sc.l + xor32_f(sc.l, c.lane);
            const float il = lt > 0.f ? fast_rcp(lt) : 0.f;
            const float mu = (sc.m == NEG_INF_F) ? 0.f : sc.m;
#define BODY_IMP(t_, st_) do { if ((t_) < ntc) { \
            const LAS unsigned char* base_ = c.lds + NSA_RING + (st_) * NSA_STAGE; bf16x8 kf[4]; \
            _Pragma("unroll") for (int s = 0; s < 4; ++s) kf[s] = *(const LAS bf16x8*)(base_ + r * 128 + (((2 * s + h) ^ (r & 7)) << 4)); \
            f32x16 S = qk_tile(kf, qf); const unsigned vm = pc.vmask((t_) * 32); \
            _Pragma("unroll") for (int i = 0; i < 16; ++i) S[i] = ((vm >> i) & 1u) ? fast_exp2(S[i] - mu) * il : 0.f; \
            _Pragma("unroll") for (int k = 0; k < 4; ++k) { \
                float gs = (S[4 * k] + S[4 * k + 1]) + (S[4 * k + 2] + S[4 * k + 3]), ls = S[4 * k + 3]; \
                gs += swz_xor<1>(gs); gs += swz_xor<2>(gs); ls += swz_xor<1>(ls); ls += swz_xor<2>(ls); \
                const int n = 8 * (t_) + 2 * k + h; \
                if (g == 0) { GL[ql * 64 + n] = gs; LL[ql * 64 + n] = ls; } } } } while (0)
            NSA_STREAM(sc_, 0, ntcW, TAKE_ALL, BODY_IMP);
            asm volatile("s_waitcnt lgkmcnt(0)" ::: "memory");
            const int qs = c.lane >> 3, part = c.lane & 7;
            float mine[8]; int cnt[8];
#pragma unroll
            for (int j = 0; j < 8; ++j) { const int n = part * 8 + j; mine[j] = GL[qs * 64 + n] + (n > 0 ? LL[qs * 64 + n - 1] : 0.f); cnt[j] = 0; }
#pragma nounroll
            for (int m = 1; m <= cur - 2; ++m) {
                const float vm = GL[qs * 64 + m] + LL[qs * 64 + m - 1];
#pragma unroll
                for (int j = 0; j < 8; ++j) { const int n = part * 8 + j; cnt[j] += (vm > mine[j] || (vm == mine[j] && m < n)) ? 1 : 0; }
            }
            unsigned byte = 0;
#pragma unroll
            for (int j = 0; j < 8; ++j) { const int n = part * 8 + j;
                const bool sel = (n == 0) || (n == cur) || (n == cur - 1) || (n >= 1 && n <= cur - 2 && cnt[j] < 13);
                byte |= sel ? (1u << j) : 0u; }
            unsigned lo = 0, hi = 0;
#pragma unroll
            for (int pp = 0; pp < 4; ++pp) { lo |= (unsigned)bperm_i(qs * 8 + pp, (int)byte) << (8 * pp); hi |= (unsigned)bperm_i(qs * 8 + 4 + pp, (int)byte) << (8 * pp); }
            mlo = (unsigned)bperm_i(ql * 8, (int)lo); mhi = (unsigned)bperm_i(ql * 8, (int)hi);
            unsigned olo = lo, ohi = hi;
            olo |= (unsigned)swz_xor_i<8>((int)olo); ohi |= (unsigned)swz_xor_i<8>((int)ohi); olo |= (unsigned)swz_xor_i<16>((int)olo); ohi |= (unsigned)swz_xor_i<16>((int)ohi);
            olo |= (unsigned)bperm_i(c.lane ^ 32, (int)olo); ohi |= (unsigned)bperm_i(c.lane ^ 32, (int)ohi);
            LAS unsigned* wgm = (LAS unsigned*)(c.lds + NSA_WGM);
            if (c.lane == 0) { wgm[2 * w] = olo; wgm[2 * w + 1] = ohi; }
            asm volatile("s_waitcnt lgkmcnt(0)" ::: "memory");
            __builtin_amdgcn_s_barrier();
            unsigned a = 0, bb = 0;
#pragma unroll
            for (int q = 0; q < 8; ++q) { a |= wgm[2 * q]; bb |= wgm[2 * q + 1]; }
            wlo = (unsigned)uni((int)a); whi = (unsigned)uni((int)bb);
        }
    }
    {
        NsaSrc ss_; ss_.kb = c.w<bf16_t>(N_KS) + (size_t)b * SEQ * 256 + kvh * 64; ss_.vb = c.w<bf16_t>(N_VTS) + (size_t)bk * 64 * 4096; ss_.kstride = 256; ss_.vstride = 4096;
        PolSel ps; ps.kb = ss_.kb; ps.vb = ss_.vb; ps.t = t; ps.t0 = t0; ps.h = h; ps.mlo = mlo; ps.mhi = mhi;
        FlashState ss; flash_init(ss);
        const int nts = ((t0 + 7) >> 5) + 1;
#define TAKE_SEL(t_) ((((t_) >> 1) < 32 ? (wlo >> ((t_) >> 1)) : (whi >> (((t_) >> 1) - 32))) & 1u)
#define BODY_SEL(t_, st_) do { if ((t_) < nts && !ps.skip(t_)) { bf16x8 kf[4], vf[4]; nsa_frag(c, st_, r, h, kf, vf); const f32x16 S = qk_tile(kf, qf); \
            const bool nm = ps.need_mask(t_); flash_tile(ss, S, vf, nm, nm ? ps.vmask((t_) * 32) : 0u, c.lane); } } while (0)
        NSA_STREAM(ss_, 0, 2 * P + 2, TAKE_SEL, BODY_SEL);
        flash_accum<false>(ss, g1, ot, c.lane);
    }
    {
        NsaSrc sw_; sw_.kb = c.w<bf16_t>(N_KW) + (size_t)b * SEQ * 256 + kvh * 64; sw_.vb = c.w<bf16_t>(N_VTW) + (size_t)bk * 64 * 4096; sw_.kstride = 256; sw_.vstride = 4096;
        PolWin pw; pw.kb = sw_.kb; pw.vb = sw_.vb; pw.t = t; pw.t0 = t0; pw.h = h;
        FlashState sw; flash_init(sw);
        const int wlo_t = (t0 - 511 > 0 ? t0 - 511 : 0) >> 5, whi_t = (t0 + 7) >> 5;
        const int W0 = (P * 64 - 511 > 0 ? P * 64 - 511 : 0) >> 5;
#define BODY_WIN(t_, st_) do { if ((t_) >= wlo_t && (t_) <= whi_t) { bf16x8 kf[4], vf[4]; nsa_frag(c, st_, r, h, kf, vf); const f32x16 S = qk_tile(kf, qf); \
            const bool nm = pw.need_mask(t_); flash_tile(sw, S, vf, nm, nm ? pw.vmask((t_) * 32) : 0u, c.lane); } } while (0)
        NSA_STREAM(sw_, W0, 2 * P + 2, TAKE_ALL, BODY_WIN);
        flash_accum<false>(sw, g2, ot, c.lane);
    }
    f32x16 ot0, ot1;
#pragma unroll
    for (int i = 0; i < 16; ++i) { ot0[i] = ot[i * 64 + c.lane]; ot1[i] = ot[(16 + i) * 64 + c.lane]; }
    store_o(c.w<bf16_t>(N_O) + (size_t)gtok * 1024 + head * 64, ot0, ot1, h);
}

DEV void nsa_attn_phase() {
    const Ctx c = make_ctx();
    for (int I = c.vcu; I < 2048; I += c.G) {
        int bk, P;
        if (c.G == 256) { const int x = c.vcu >> 5, l = c.vcu & 31, j = I >> 8, I2 = j * 32 + l; bk = 4 * x + (I2 & 3); const int pi = I2 >> 2; P = (j & 1) ? (8 * j + 7 - (pi & 7)) : pi; }
        else { bk = I & 31; P = I >> 5; }
        nsa_unit(c, bk >> 2, bk & 3, P);
    }
    asm volatile("s_waitcnt vmcnt(0)" ::: "memory");
    __syncthreads();
}

DEV void nsa_cmp2_phase() {
    const Ctx c = make_ctx();
    const bf16_t* HC = c.w<bf16_t>(N_HC); const bf16_t* W2 = c.w<bf16_t>(WS_WMIX) + NW_W2;
    bf16_t* KC = c.w<bf16_t>(N_KCMP); bf16_t* VT = c.w<bf16_t>(N_VCMPT);
    const int r = c.lane & 31, h = c.lane >> 5, NW = c.G * NWAVE, wg = c.vcu * NWAVE + c.wave;
    for (int u = wg; u < 512; u += NW) {
        const int row0 = u * 32, which = row0 >> 13;
        const bf16_t* w2 = W2 + (size_t)which * 64 * 256;
        f32x16 a0, a1;
#pragma unroll
        for (int i = 0; i < 16; ++i) { a0[i] = 0.f; a1[i] = 0.f; }
        const bf16_t* ap = HC + (size_t)(row0 + r) * 256 + 8 * h;
#pragma unroll 4
        for (int ks = 0; ks < 16; ++ks) {
            const bf16x8 af = *(const bf16x8*)(ap + ks * 16);
            const bf16x8 b0 = *(const bf16x8*)(w2 + (size_t)r * 256 + ks * 16 + 8 * h);
            const bf16x8 b1 = *(const bf16x8*)(w2 + (size_t)(32 + r) * 256 + ks * 16 + 8 * h);
            a0 = __builtin_amdgcn_mfma_f32_32x32x16_bf16(af, b0, a0, 0, 0, 0);
            a1 = __builtin_amdgcn_mfma_f32_32x32x16_bf16(af, b1, a1, 0, 0, 0);
        }
        const int R = row0 & 8191, bkk = R >> 8, c0 = R & 255;
        if (which == 0) {
#pragma unroll
            for (int i = 0; i < 16; ++i) { const int cc = c0 + (i & 3) + 8 * (i >> 2) + 4 * h;
                KC[((size_t)bkk * 256 + cc) * 64 + r] = f2bf(a0[i]); KC[((size_t)bkk * 256 + cc) * 64 + 32 + r] = f2bf(a1[i]); }
        } else {
#pragma unroll
            for (int a = 0; a < 4; ++a) { const int cc = c0 + 8 * a + 4 * h;
                const int pos = (cc & ~15) + 8 * ((cc >> 2) & 1) + 4 * ((cc >> 3) & 1);
                u32x2 w; w.x = cvt_pk_bf16(a0[4 * a], a0[4 * a + 1]); w.y = cvt_pk_bf16(a0[4 * a + 2], a0[4 * a + 3]);
                *(u32x2*)(VT + ((size_t)bkk * 64 + r) * 256 + pos) = w;
                u32x2 x; x.x = cvt_pk_bf16(a1[4 * a], a1[4 * a + 1]); x.y = cvt_pk_bf16(a1[4 * a + 2], a1[4 * a + 3]);
                *(u32x2*)(VT + ((size_t)bkk * 64 + 32 + r) * 256 + pos) = x; }
        }
    }
}

struct PolDil {
    const bf16_t* kb; const bf16_t* vb; int u, u0, h, kstride;
    DEV const bf16_t* kptr(int key) const { return kb + (size_t)key * kstride; }
    DEV const bf16_t* vptr(int d) const { return vb + (size_t)d * 4096; }
    DEV bool skip(int) const { return false; }
    DEV bool need_mask(int tile) const { return (tile * 32 + 31 > u0) || (tile * 32 < u0 + 31 - 128); }
    DEV unsigned vmask(int key0) const { unsigned m = 0;
#pragma unroll
        for (int i = 0; i < 16; ++i) { const int dd = u - key_of(key0, i, h); m |= (dd >= 0 && dd <= 128) ? (1u << i) : 0u; }
        return m; }
};
DEV void dil_attn_phase() {
    const Ctx c = make_ctx();
    const int r = c.lane & 31, h = c.lane >> 5, NW = c.G * NWAVE, wg = c.vcu * NWAVE + c.wave;
    for (int I = wg; I < 3 * 16384; I += NW) {
        const int g = I >> 14, J = I & 16383, bh = J >> 7, W = J & 127, b = bh >> 4, head = bh & 15;
        const int sh = 2 * g, L = SEQ >> sh, nub = L >> 5;
        const int rc = W / nub, ublk = W - rc * nub;
        const int u0 = ublk * 32, u = u0 + r, tok = b * SEQ + (u << sh) + rc;
        const bf16_t* Qd = c.w<bf16_t>(D_Q) + (size_t)g * NTOK * 1024;
        bf16x8 qf[4];
#pragma unroll
        for (int s = 0; s < 4; ++s) qf[s] = *(const bf16x8*)(Qd + (size_t)tok * 1024 + head * 64 + 16 * s + 8 * h);
        PolDil pd; pd.kb = c.w<bf16_t>(D_K) + (size_t)g * NTOK * 1024 + ((size_t)b * SEQ + rc) * 1024 + head * 64; pd.kstride = 1024 << sh;
        pd.vb = c.w<bf16_t>(D_VT) + ((size_t)((g * 8 + b) * 16 + head) * 64) * 4096 + rc * L; pd.u = u; pd.u0 = u0; pd.h = h;
        FlashState st; flash_init(st);
        flash_run(pd, qf, st, (ublk > 4 ? ublk - 4 : 0), ublk + 1, r, h);
        const float lt = st.l + xor32_f(st.l, c.lane);
        const float sc = fast_rcp(lt);
        f32x16 o0, o1;
#pragma unroll
        for (int i = 0; i < 16; ++i) { o0[i] = st.o0[i] * sc; o1[i] = st.o1[i] * sc; }
        store_o(c.w<bf16_t>(D_OG) + (size_t)g * NTOK * 1024 + (size_t)tok * 1024 + head * 64, o0, o1, h);
        if (h == 0) c.w<float>(D_LSE)[(size_t)g * NTOK * 16 + (size_t)tok * 16 + head] = st.m + __log2f(lt);
    }
}
DEV void dil_merge_phase() {
    const Ctx c = make_ctx();
    const bf16_t* OG = c.w<bf16_t>(D_OG); const float* LS = c.w<float>(D_LSE); bf16_t* O = c.w<bf16_t>(D_O);
    for (size_t i = (size_t)c.vcu * NTHR + c.tid; i < (size_t)NTOK * 128; i += (size_t)c.G * NTHR) {
        const size_t tok = i >> 7; const int chunk = (int)(i & 127), head = chunk >> 3;
        const float l0 = LS[tok * 16 + head], l1 = LS[(size_t)NTOK * 16 + tok * 16 + head], l2 = LS[(size_t)2 * NTOK * 16 + tok * 16 + head];
        const float mx = fmaxf(l0, fmaxf(l1, l2));
        const float e0 = fast_exp2(l0 - mx), e1 = fast_exp2(l1 - mx), e2 = fast_exp2(l2 - mx), inv = fast_rcp(e0 + e1 + e2);
        const u32x4 a = *(const u32x4*)(OG + tok * 1024 + chunk * 8), bq = *(const u32x4*)(OG + (size_t)NTOK * 1024 + tok * 1024 + chunk * 8), cq = *(const u32x4*)(OG + (size_t)2 * NTOK * 1024 + tok * 1024 + chunk * 8);
        u32x4 o;
#pragma unroll
        for (int j = 0; j < 4; ++j) {
            const float lo = (bflo(a[j]) * e0 + bflo(bq[j]) * e1 + bflo(cq[j]) * e2) * inv, hi = (bfhi(a[j]) * e0 + bfhi(bq[j]) * e1 + bfhi(cq[j]) * e2) * inv;
            o[j] = cvt_pk_bf16(lo, hi);
        }
        *(u32x4*)(O + tok * 1024 + chunk * 8) = o;
    }
}

constexpr int GL_QG = 0, GL_KG = 17408, GL_KDT = 34816, GL_VT = 53248, GL_AS = 90112, GL_ALR = 99328, GL_SEG = 103424;
DEV float logsigmoid_(float z) {
    const float e = fast_exp2(-fabsf(z) * LOG2E);
    return fminf(z, 0.f) - __log2f(1.f + e) * 0.6931471805599453f;
}
DEV void gla_a_phase(const float* w_a2, const float* b_a) {
    const Ctx c = make_ctx();
    const bf16_t* Qg = c.w<bf16_t>(G_Q); const bf16_t* Kg = c.w<bf16_t>(G_K); const float* ALR = c.w<float>(G_ALR); const bf16_t* VTg = c.w<bf16_t>(G_VT);
    float* OI = c.w<float>(G_OI); bf16_t* QGo = c.w<bf16_t>(G_QG); bf16_t* DST = c.w<bf16_t>(G_DST); float* DEC = c.w<float>(G_DEC);
    LAS bf16_t* sQG = (LAS bf16_t*)(c.lds + GL_QG); LAS bf16_t* sKG = (LAS bf16_t*)(c.lds + GL_KG);
    LAS bf16_t* sKDT = (LAS bf16_t*)(c.lds + GL_KDT);
    LAS bf16_t* sVT = (LAS bf16_t*)(c.lds + GL_VT);
    LAS bf16_t* sA = (LAS bf16_t*)(c.lds + GL_AS);
    LAS float* sALR = (LAS float*)(c.lds + GL_ALR);
    LAS float* sSEG = (LAS float*)(c.lds + GL_SEG);
    const int fr = c.lane & 15, fq = c.lane >> 4, w = c.wave;
    for (int unit = c.vcu; unit < NB * 64 * 4; unit += c.G) {
        const int hd = unit & 3, n = (unit >> 2) & 63, b = unit >> 8;
        const int tok0 = b * SEQ + n * 64;
        if (c.tid < 256) *(LAS f32x4*)(sALR + (c.tid >> 2) * 16 + (c.tid & 3) * 4) = *(const f32x4*)(ALR + (size_t)(tok0 + (c.tid >> 2)) * 16 + (c.tid & 3) * 4);
#pragma unroll
        for (int q = 0; q < 4; ++q) {
            const int id = c.tid + 512 * q, e = id >> 3, cc = (id & 7) * 8;
            *(LAS u32x4*)(sVT + e * 72 + cc) = *(const u32x4*)(VTg + ((size_t)(b * 1024 + hd * 256 + e)) * 4096 + n * 64 + cc);
        }
        __syncthreads();
        {
            const int d = c.tid & 127, seg = c.tid >> 7;
            float wa[16];
#pragma unroll
            for (int r = 0; r < 16; ++r) wa[r] = w_a2[r * 512 + hd * 128 + d];
            const float ba = b_a[hd * 128 + d];
            float cum[16]; float run = 0.f;
#pragma unroll
            for (int cc = 0; cc < 16; ++cc) {
                const LAS float* ar = sALR + (seg * 16 + cc) * 16;
                float z = ba;
#pragma unroll
                for (int r = 0; r < 16; ++r) z += ar[r] * wa[r];
                run += logsigmoid_(z) * (1.f / 16.f); cum[cc] = run;
            }
            sSEG[seg * 128 + d] = run;
            __syncthreads();
            float off = 0.f, blast = 0.f;
#pragma unroll
            for (int s = 0; s < 4; ++s) { const float v = sSEG[s * 128 + d]; off += (s < seg) ? v : 0.f; blast += v; }
#pragma unroll
            for (int cc = 0; cc < 16; ++cc) {
                const int cpos = seg * 16 + cc; const float bcd = cum[cc] + off;
                const float qv = bf2f(Qg[(size_t)(tok0 + cpos) * 512 + hd * 128 + d]), kv = bf2f(Kg[(size_t)(tok0 + cpos) * 512 + hd * 128 + d]);
                const float eb = fast_exp2(bcd * LOG2E);
                const bf16_t qg = f2bf(qv * eb * 0.08838834764831845f), kg = f2bf(kv * fast_rcp(eb)), kd = f2bf(kv * fast_exp2((blast - bcd) * LOG2E));
                sQG[cpos * 136 + d] = qg; sKG[cpos * 136 + d] = kg; sKDT[d * 72 + cpos] = kd;
                QGo[(size_t)(tok0 + cpos) * 512 + hd * 128 + d] = qg;
            }
            if (seg == 0) DEC[((size_t)((b * 64 + n) * 4 + hd)) * 128 + d] = fast_exp2(blast * LOG2E);
        }
        __syncthreads();
        {
            const int it = w >> 1;
#pragma unroll
            for (int jj = 0; jj < 2; ++jj) {
                const int jt = 2 * (w & 1) + jj;
                f32x4 acc = {0.f, 0.f, 0.f, 0.f};
#pragma unroll
                for (int ks = 0; ks < 4; ++ks) {
                    const bf16x8 a = *(const LAS bf16x8*)(sKG + (jt * 16 + fr) * 136 + ks * 32 + fq * 8);
                    const bf16x8 bq = *(const LAS bf16x8*)(sQG + (it * 16 + fr) * 136 + ks * 32 + fq * 8);
                    acc = __builtin_amdgcn_mfma_f32_16x16x32_bf16(a, bq, acc, 0, 0, 0);
                }
                const int i = it * 16 + fr, j0 = jt * 16 + fq * 4;
                u32x2 wv; wv.x = cvt_pk_bf16(i >= j0 ? acc[0] : 0.f, i >= j0 + 1 ? acc[1] : 0.f); wv.y = cvt_pk_bf16(i >= j0 + 2 ? acc[2] : 0.f, i >= j0 + 3 ? acc[3] : 0.f);
                *(LAS u32x2*)(sA + i * 72 + j0) = wv;
            }
        }
        __syncthreads();
        {
            const int e0 = w * 32;
            f32x4 acc[2][4];
#pragma unroll
            for (int et = 0; et < 2; ++et)
#pragma unroll
                for (int it = 0; it < 4; ++it) acc[et][it] = (f32x4){0.f, 0.f, 0.f, 0.f};
#pragma unroll
            for (int ks = 0; ks < 2; ++ks) {
                bf16x8 bi[4];
#pragma unroll
                for (int it = 0; it < 4; ++it) bi[it] = *(const LAS bf16x8*)(sA + (it * 16 + fr) * 72 + ks * 32 + fq * 8);
#pragma unroll
                for (int et = 0; et < 2; ++et) {
                    const bf16x8 a = *(const LAS bf16x8*)(sVT + (e0 + et * 16 + fr) * 72 + ks * 32 + fq * 8);
#pragma unroll
                    for (int it = 0; it < 4; ++it) acc[et][it] = __builtin_amdgcn_mfma_f32_16x16x32_bf16(a, bi[it], acc[et][it], 0, 0, 0);
                }
            }
#pragma unroll
            for (int et = 0; et < 2; ++et)
#pragma unroll
                for (int it = 0; it < 4; ++it)
                    *(f32x4*)(OI + (size_t)(tok0 + it * 16 + fr) * 1024 + hd * 256 + e0 + et * 16 + fq * 4) = acc[et][it];
        }
        {
            const int e0 = w * 32;
#pragma unroll
            for (int et = 0; et < 2; ++et) {
                f32x4 acc[8];
#pragma unroll
                for (int dt = 0; dt < 8; ++dt) acc[dt] = (f32x4){0.f, 0.f, 0.f, 0.f};
#pragma unroll
                for (int ks = 0; ks < 2; ++ks) {
                    const bf16x8 bq = *(const LAS bf16x8*)(sVT + (e0 + et * 16 + fr) * 72 + ks * 32 + fq * 8);
#pragma unroll
                    for (int dt = 0; dt < 8; ++dt) {
                        const bf16x8 a = *(const LAS bf16x8*)(sKDT + (dt * 16 + fr) * 72 + ks * 32 + fq * 8);
                        acc[dt] = __builtin_amdgcn_mfma_f32_16x16x32_bf16(a, bq, acc[dt], 0, 0, 0);
                    }
                }
                bf16_t* dp = DST + (((size_t)((b * 4 + hd) * 64 + n)) * 256 + e0 + et * 16 + fr) * 128 + fq * 4;
#pragma unroll
                for (int dt = 0; dt < 8; ++dt) { u32x2 wv; wv.x = cvt_pk_bf16(acc[dt][0], acc[dt][1]); wv.y = cvt_pk_bf16(acc[dt][2], acc[dt][3]); *(u32x2*)(dp + dt * 16) = wv; }
            }
        }
        __syncthreads();
    }
}

DEV void gla_b_phase() {
    const Ctx c = make_ctx();
    float* OI = c.w<float>(G_OI); const bf16_t* QG = c.w<bf16_t>(G_QG); const bf16_t* DST = c.w<bf16_t>(G_DST); const float* DEC = c.w<float>(G_DEC);
    const int fr = c.lane & 15, fq = c.lane >> 4, NW = c.G * NWAVE, wg = c.vcu * NWAVE + c.wave;
    for (int I = wg; I < 2048; I += NW) {
        const int it = I & 3, et = (I >> 2) & 15, hd = (I >> 6) & 3, b = I >> 8;
        float S[4][8];
#pragma unroll
        for (int ks = 0; ks < 4; ++ks)
#pragma unroll
            for (int j = 0; j < 8; ++j) S[ks][j] = 0.f;
        const bf16_t* qp = QG + (size_t)(b * SEQ + it * 16 + fr) * 512 + hd * 128 + fq * 8;
        const bf16_t* dp = DST + (((size_t)(b * 4 + hd) * 64) * 256 + et * 16 + fr) * 128 + fq * 8;
        const float* cp = DEC + ((size_t)(b * 64) * 4 + hd) * 128 + fq * 8;
        float* op = OI + (size_t)(b * SEQ + it * 16 + fq * 4) * 1024 + hd * 256 + et * 16 + fr;
        for (int n = 0; n < 64; ++n) {
            bf16x8 qf[4]; u32x4 ds[4]; f32x4 dc[4][2];
#pragma unroll
            for (int ks = 0; ks < 4; ++ks) {
                qf[ks] = *(const bf16x8*)(qp + (size_t)n * 64 * 512 + ks * 32);
                ds[ks] = *(const u32x4*)(dp + (size_t)n * 256 * 128 + ks * 32);
                dc[ks][0] = *(const f32x4*)(cp + (size_t)n * 512 + ks * 32); dc[ks][1] = *(const f32x4*)(cp + (size_t)n * 512 + ks * 32 + 4);
            }
            f32x4 acc = {0.f, 0.f, 0.f, 0.f};
#pragma unroll
            for (int ks = 0; ks < 4; ++ks) {
                u32x4 sw; sw.x = cvt_pk_bf16(S[ks][0], S[ks][1]); sw.y = cvt_pk_bf16(S[ks][2], S[ks][3]); sw.z = cvt_pk_bf16(S[ks][4], S[ks][5]); sw.w = cvt_pk_bf16(S[ks][6], S[ks][7]);
                acc = __builtin_amdgcn_mfma_f32_16x16x32_bf16(qf[ks], __builtin_bit_cast(bf16x8, sw), acc, 0, 0, 0);
            }
#pragma unroll
            for (int r = 0; r < 4; ++r) { float* o = op + (size_t)(n * 64 + r) * 1024; *o = *o + acc[r]; }
#pragma unroll
            for (int ks = 0; ks < 4; ++ks) {
#pragma unroll
                for (int j = 0; j < 4; ++j) {
                    S[ks][2 * j] = dc[ks][j >> 1][(2 * j) & 3] * S[ks][2 * j] + bflo(ds[ks][j]);
                    S[ks][2 * j + 1] = dc[ks][j >> 1][(2 * j + 1) & 3] * S[ks][2 * j + 1] + bfhi(ds[ks][j]);
                }
            }
        }
    }
}

DEV void gla_c_phase(const float* norm_g) {
    const Ctx c = make_ctx();
    const float* OI = c.w<float>(G_OI); const bf16_t* R = c.w<bf16_t>(G_R); bf16_t* GO = c.w<bf16_t>(G_O);
    const f32x4 gv = *(const f32x4*)(norm_g + c.lane * 4);
    const int NW = c.G * NWAVE, wg = c.vcu * NWAVE + c.wave;
    for (int I = wg; I < NTOK * 4; I += NW) {
        const size_t off = (size_t)(I >> 2) * 1024 + (I & 3) * 256 + c.lane * 4;
        const f32x4 v = *(const f32x4*)(OI + off);
        const float ss = wave_sum((v[0] * v[0] + v[1] * v[1]) + (v[2] * v[2] + v[3] * v[3]), c.lane);
        const float rs = __builtin_amdgcn_rsqf(ss * (1.f / 256.f) + LN_EPS);
        const u32x2 rw = *(const u32x2*)(R + off);
        u32x2 o; o.x = cvt_pk_bf16(v[0] * rs * gv[0] * bflo(rw.x), v[1] * rs * gv[1] * bfhi(rw.x)); o.y = cvt_pk_bf16(v[2] * rs * gv[2] * bflo(rw.y), v[3] * rs * gv[3] * bfhi(rw.y));
        *(u32x2*)(GO + off) = o;
    }
}

enum { S_END = 0, S_CONV_NSA, S_CMP2, S_NSA_ATTN, S_CONV_GLA, S_GLA_A, S_GLA_B, S_GLA_C, S_CONV_DIL, S_DIL_ATTN, S_DIL_MERGE, S_LN1, S_ROUTE_A, S_ROUTE_B, S_LN2,
       S_GEMM0 = 32, S_G_NSA_A = 32, S_G_NSA_V, S_G_CMP1, S_G_WOUT_N, S_G_GLA_A, S_G_GLA_V, S_G_WOUT_G, S_G_DIL_A, S_G_DIL_V, S_G_WOUT_D, S_G_MOE1, S_G_MOE2 };
__device__ const unsigned char STEPS[3][16] = {
    {S_CONV_NSA, S_G_NSA_A, S_G_NSA_V, S_G_CMP1, S_CMP2, S_NSA_ATTN, S_G_WOUT_N, S_LN1, S_ROUTE_A, S_ROUTE_B, S_G_MOE1, S_G_MOE2, S_LN2, S_END, S_END, S_END},
    {S_CONV_GLA, S_G_GLA_A, S_G_GLA_V, S_GLA_A, S_GLA_B, S_GLA_C, S_G_WOUT_G, S_LN1, S_ROUTE_A, S_ROUTE_B, S_G_MOE1, S_G_MOE2, S_LN2, S_END, S_END, S_END},
    {S_CONV_DIL, S_G_DIL_A, S_G_DIL_V, S_DIL_ATTN, S_DIL_MERGE, S_G_WOUT_D, S_LN1, S_ROUTE_A, S_ROUTE_B, S_G_MOE1, S_G_MOE2, S_LN2, S_END, S_END, S_END, S_END},
};

DEV void cmp_bias(const float* pos0, const float* w10, const float* pos1, const float* w11) {
    const Ctx c = make_ctx();
    float* bias = c.w<float>(WS_BIAS);
    LAS float* red = (LAS float*)(c.lds + 65536);
    for (int u = c.vcu; u < 64; u += c.G) {
        const int which = u >> 5, j = (u & 31) * 8 + (c.tid & 7), kl = c.tid >> 3;
        const float* pos = which ? pos1 : pos0; const float* w1 = which ? w11 : w10;
        float s = 0.f;
#pragma unroll 8
        for (int i = 0; i < 32; ++i) { const int k = kl + 64 * i; s += pos[k] * w1[(size_t)k * 256 + j]; }
        red[c.tid] = s;
        __syncthreads();
        if (c.tid < 8) { float t = 0.f; for (int q = 0; q < 64; ++q) t += red[q * 8 + c.tid]; bias[which * 256 + (u & 31) * 8 + c.tid] = t; }
        __syncthreads();
    }
}

DEV void conv_moe(int lb  ) {
    int rot = 0;
    const Ctx c = make_ctx();
    ConvJob j;
    j.src = c.in(lb + 4); j.dst = c.w<bf16_t>(WS_WE1); j.ldn = 512; j.K = 1024; j.ntn = 8; j.nvalid = 512; j.nbatch = 64; j.sbatch = (size_t)1024 * 512; j.dbatch = (size_t)512 * 1024; j.mode = 1; j.col0 = 0;
    rot = conv_run(j, rot);
    j.src = c.in(lb + 6); j.dst = c.w<bf16_t>(WS_WE1) + (size_t)64 * 512 * 1024; j.nbatch = 1;
    rot = conv_run(j, rot);
    j.src = c.in(lb + 5); j.dst = c.w<bf16_t>(WS_WE2); j.ldn = 1024; j.K = 256; j.ntn = 16; j.nvalid = 1024; j.nbatch = 64; j.sbatch = (size_t)256 * 1024; j.dbatch = (size_t)1024 * 256; j.mode = 0; j.col0 = 0;
    rot = conv_run(j, rot);
    j.src = c.in(lb + 7); j.dst = c.w<bf16_t>(WS_WE2) + (size_t)64 * 1024 * 256; j.nbatch = 1;
    rot = conv_run(j, rot);
    conv_router(c.in(lb + 2), c.w<bf16_t>(WS_WR));
}

static_assert(sizeof(GemmDesc) <= 192, "GemmDesc slot");
DEV void gemm_table() {
    const Ctx c = make_ctx();
    if (c.tid < 12) {
        const int step = S_GEMM0 + c.tid;
        bf16_t* XB = c.w<bf16_t>(WS_XB); bf16_t* WM = c.w<bf16_t>(WS_WMIX); int* meta = c.w<int>(WS_META);
        LAS GemmDesc& d = *(LAS GemmDesc*)(c.lds + LDS_DESC + c.tid * 192);
        d.lda = 1024; d.ldb = 1024; d.K = 1024; d.kstepA = 64; d.nM = 128; d.nN = 4; d.nM_ptr = nullptr; d.amode = AM_ID; d.aidx = nullptr; d.bmode = BM_ID; d.tile_e = nullptr; d.bstride = 0;
        d.o0 = nullptr; d.o1 = nullptr; d.o2 = nullptr; d.o3 = nullptr; d.f0 = nullptr; d.f1 = nullptr; d.A = XB; d.Bt = WM; d.epi = EPI_WOUT;
        switch (step) {
        case S_G_NSA_A: d.Bt = WM + NW_A; d.nN = 9; d.epi = EPI_NSA_A; d.o0 = c.w<void>(N_Q); d.o1 = c.w<void>(N_KCVC); d.o2 = c.w<void>(N_GATE); break;
        case S_G_NSA_V: d.A = WM + NW_V; d.Bt = XB; d.nM = 2; d.nN = 128; d.epi = EPI_NSA_V; d.o0 = c.w<void>(N_VTS); break;
        case S_G_CMP1:  d.A = c.w<bf16_t>(N_KCVC); d.lda = 16 * 256; d.kstepA = 256; d.amode = AM_CMP; d.K = 2048; d.Bt = WM + NW_W1; d.ldb = 2048; d.bmode = BM_EXP; d.tile_e = meta + META_TILE + 1280; d.bstride = (size_t)256 * 2048;
                        d.nM = 64; d.nN = 1; d.epi = EPI_CMP1; d.o0 = c.w<void>(N_HC); d.f0 = c.w<float>(WS_BIAS); break;
        case S_G_WOUT_N: d.A = c.w<bf16_t>(N_O); d.Bt = WM + NW_OUT; d.o0 = c.xf; break;
        case S_G_GLA_A: d.Bt = WM + GW_A; d.nN = 9; d.epi = EPI_GLA_A; d.o0 = c.w<void>(G_Q); d.o1 = c.w<void>(G_R); d.o2 = c.w<void>(G_ALR); break;
        case S_G_GLA_V: d.A = WM + GW_V; d.Bt = XB; d.nM = 4; d.nN = 128; d.epi = EPI_GLA_V; d.o0 = c.w<void>(G_VT); break;
        case S_G_WOUT_G: d.A = c.w<bf16_t>(G_O); d.Bt = WM + GW_OUT; d.o0 = c.xf; break;
        case S_G_DIL_A: d.Bt = WM + DW_A; d.nN = 24; d.epi = EPI_DIL_A; d.o0 = c.w<void>(D_Q); d.o1 = c.w<void>(D_K); break;
        case S_G_DIL_V: d.A = WM + DW_V; d.Bt = XB; d.nM = 12; d.nN = 128; d.bmode = BM_DIL; d.epi = EPI_DIL_V; d.o0 = c.w<void>(D_VT); break;
        case S_G_WOUT_D: d.A = c.w<bf16_t>(D_O); d.Bt = WM + DW_OUT; d.o0 = c.xf; break;
        case S_G_MOE1:  d.A = XB; d.amode = AM_IDX; d.aidx = c.w<int>(A_ROWTOK); d.Bt = c.w<bf16_t>(WS_WE1); d.bmode = BM_EXP; d.tile_e = meta + META_TILE; d.bstride = (size_t)512 * 1024;
                        d.nM_ptr = meta + META_NMT; d.nN = 2; d.epi = EPI_MOE1; d.o0 = c.w<void>(A_H); break;
        case S_G_MOE2:  d.A = c.w<bf16_t>(A_H); d.lda = 256; d.K = 256; d.Bt = c.w<bf16_t>(WS_WE2); d.ldb = 256; d.bmode = BM_EXP; d.tile_e = meta + META_TILE; d.bstride = (size_t)1024 * 256;
                        d.nM_ptr = meta + META_NMT; d.nN = 4; d.epi = EPI_MOE2; d.o0 = c.w<void>(A_Y); d.o1 = c.xf; d.o2 = c.w<void>(A_ROWTOK); d.f0 = c.w<float>(A_ROWGATE); break;
        default: break;
        }
    }
    __syncthreads();
}

DEV void conv_nsa(int mb) {
    const Ctx c = make_ctx(); bf16_t* WM = c.w<bf16_t>(WS_WMIX); int rot = 0;
    const float* win = c.in(mb);
    rot = conv(win, 2608, 0, 1280, 1280, 1024, WM + NW_A, rot);
    rot = conv(win, 2608, 1280, 256, 256, 1024, WM + NW_A + (size_t)1280 * 1024, rot);
    rot = conv(win, 2608, 1536, 256, 256, 1024, WM + NW_A + (size_t)1536 * 1024, rot);
    rot = conv(win, 2608, 2048, 256, 256, 1024, WM + NW_A + (size_t)1792 * 1024, rot);
    rot = conv(win, 2608, 2560, 48, 256, 1024, WM + NW_A + (size_t)2048 * 1024, rot);
    rot = conv(win, 2608, 1792, 256, 256, 1024, WM + NW_V, rot);
    rot = conv(win, 2608, 2304, 256, 256, 1024, WM + NW_V + (size_t)256 * 1024, rot);
    rot = conv(c.in(mb + 3), 256, 0, 256, 256, 2048, WM + NW_W1, rot);
    rot = conv(c.in(mb + 6), 256, 0, 256, 256, 2048, WM + NW_W1 + (size_t)256 * 2048, rot);
    rot = conv(c.in(mb + 1), 1024, 0, 1024, 1024, 1024, WM + NW_OUT, rot);
    rot = conv(c.in(mb + 4), 64, 0, 64, 64, 256, WM + NW_W2, rot);
    rot = conv(c.in(mb + 7), 64, 0, 64, 64, 256, WM + NW_W2 + (size_t)64 * 256, rot);
    cmp_bias(c.in(mb + 2), c.in(mb + 3), c.in(mb + 5), c.in(mb + 6));
}
DEV void conv_gla(int mb) {
    const Ctx c = make_ctx(); bf16_t* WM = c.w<bf16_t>(WS_WMIX); int rot = 0;
    const float* win = c.in(mb);
    rot = conv(win, 3088, 0, 1024, 1024, 1024, WM + GW_A, rot);
    rot = conv(win, 3088, 2064, 1024, 1024, 1024, WM + GW_A + (size_t)1024 * 1024, rot);
    rot = conv(win, 3088, 2048, 16, 256, 1024, WM + GW_A + (size_t)2048 * 1024, rot);
    rot = conv(win, 3088, 1024, 1024, 1024, 1024, WM + GW_V, rot);
    rot = conv(c.in(mb + 4), 1024, 0, 1024, 1024, 1024, WM + GW_OUT, rot);
}
DEV void conv_dil(int mb) {
    const Ctx c = make_ctx(); bf16_t* WM = c.w<bf16_t>(WS_WMIX); int rot = 0;
    const float* win = c.in(mb);
    for (int g = 0; g < 3; ++g) {
        rot = conv(win, 9216, g * 3072, 2048, 2048, 1024, WM + DW_A + (size_t)g * 2048 * 1024, rot);
        rot = conv(win, 9216, g * 3072 + 2048, 1024, 1024, 1024, WM + DW_V + (size_t)g * 1024 * 1024, rot);
    }
    rot = conv(c.in(mb + 1), 1024, 0, 1024, 1024, 1024, WM + DW_OUT, rot);
}
DEV const float* inptr(int i) { const Ctx c = make_ctx(); return c.in(i); }

__global__ void __launch_bounds__(NTHR, 2) fwd(Args args) {
    extern __shared__ __attribute__((aligned(16))) unsigned char lds_raw[];
    LAS unsigned char* lds = (LAS unsigned char*)lds_raw;
    if (threadIdx.x < 4) ((LAS unsigned*)(lds + LDS_MISC))[threadIdx.x] = 0u;
    if (threadIdx.x == 0) {
        *(unsigned char* LAS*)(lds + LDS_MISC + 16) = args.ws; *(float* LAS*)(lds + LDS_MISC + 24) = args.out;
#pragma unroll
        for (int i = 0; i < 64; ++i) ((const float* LAS*)(lds + LDS_MISC + 64))[i] = args.in[i];
    }
    __syncthreads();
    { const Ctx c = make_ctx(); (void)xcd_barrier_post((unsigned*)c.ws + CW_BAR, (volatile LAS unsigned*)(lds + LDS_MISC));
      if (c.vcu == 0 && c.tid < 64) c.w<int>(WS_META)[META_TILE + 1280 + c.tid] = c.tid >> 5;
      if (c.tid == 0) { *(LAS int*)(lds + LDS_MISC + 32) = 0; *(LAS int*)(lds + LDS_MISC + 40) = 0;
#ifdef PROBE_T
        volatile LAS unsigned long long* T = (volatile LAS unsigned long long*)(lds + LDS_MISC + 600); T[0] = __builtin_amdgcn_s_memrealtime(); T[1] = 0;
#endif
      } }
    gemm_table();
    prologue();
    for (;;) {
        __syncthreads();
        int pc = *(volatile LAS int*)(lds + LDS_MISC + 32);
        pc = __builtin_amdgcn_readfirstlane(pc);
        const int L = pc >> 4, si = pc & 15;
        if (L >= 4) break;
        const int kind = (L == 3) ? 0 : L;
        const int mb = (L == 0) ? 1 : (L == 1) ? 19 : (L == 2) ? 34 : 46;
        const int lb = (L == 0) ? 9 : (L == 1) ? 24 : (L == 2) ? 36 : 54;
        const int step = STEPS[kind][si];
        __syncthreads();
#ifdef REPEAT_MASK
        if (threadIdx.x == 0) {
            volatile LAS int* rep = (volatile LAS int*)(lds + LDS_MISC + 40);
            const bool again = (step != S_END) && ((REPEAT_MASK >> step) & 1ull) && (*rep == 0);
            *rep = again ? 1 : 0;
            *(volatile LAS int*)(lds + LDS_MISC + 32) = again ? pc : ((step == S_END || si == 15) ? (L + 1) * 16 : pc + 1);
        }
#else
        if (threadIdx.x == 0) *(volatile LAS int*)(lds + LDS_MISC + 32) = (step == S_END || si == 15) ? (L + 1) * 16 : pc + 1;
#endif
        if (step == S_END) continue;
        if (step >= S_GEMM0) gemm_phase(step - S_GEMM0);
        else {
            switch (step) {
            case S_CONV_NSA: conv_nsa(mb); break;
            case S_CMP2: nsa_cmp2_phase(); break;
            case S_NSA_ATTN: nsa_attn_phase(); break;
            case S_CONV_GLA: conv_gla(mb); break;
            case S_GLA_A: gla_a_phase(inptr(mb + 1), inptr(mb + 2)); break;
            case S_GLA_B: gla_b_phase(); break;
            case S_GLA_C: gla_c_phase(inptr(mb + 3)); break;
            case S_CONV_DIL: conv_dil(mb); break;
            case S_DIL_ATTN: dil_attn_phase(); break;
            case S_DIL_MERGE: dil_merge_phase(); break;
            case S_LN1: ln_phase<0>(inptr(lb), inptr(lb + 1)); conv_moe(lb); break;
            case S_ROUTE_A: route_a(inptr(lb + 3)); break;
            case S_ROUTE_B: route_b(); break;
            case S_LN2: ln_phase<1>(inptr(lb + 8), inptr(lb + 9)); break;
            default: break;
            }
        }
        { const Ctx c = make_ctx(); XcdBarrier bar; bar.bar = (unsigned*)c.ws + CW_BAR; bar.x = xb_xcc_id(); bar.st = (volatile LAS unsigned*)(c.lds + LDS_MISC); xcd_barrier(bar); }
#ifdef PROBE_T
        if (threadIdx.x == 0) {
            volatile LAS unsigned long long* T = (volatile LAS unsigned long long*)(lds + LDS_MISC + 600);
            const unsigned long long now = __builtin_amdgcn_s_memrealtime(), d = now - T[0]; T[0] = now;
            if ((PROBE_T >> step) & 1ull) T[1] += d;
        }
#endif
    }
#ifdef PROBE_T
    {
        const Ctx c = make_ctx();
        if (blockIdx.x == 0 && c.tid == 0) {
            volatile LAS unsigned long long* T = (volatile LAS unsigned long long*)(lds + LDS_MISC + 600);
            c.xf[0] += floorf((float)T[1] * (0.01f / (float)PROBE_UNIT_US));
        }
    }
#endif
}

extern "C" void kernel_launch(void* const* d_in, const int* in_sizes, int n_in, void* d_out, int out_size, void* d_ws, size_t ws_size, hipStream_t stream) {
    static int grid = 0;
    if (grid == 0) {
        if (n_in != 64 || out_size != NTOK * DM || ws_size < WS_NEED) { fprintf(stderr, "kernel_launch: unexpected problem (n_in %d, out %d, ws %zu, need %zu)\n", n_in, out_size, ws_size, (size_t)WS_NEED); grid = -1; return; }
        int dev = 0, cus = 0, per_cu = 0;
        if (hipGetDevice(&dev) != hipSuccess || hipDeviceGetAttribute(&cus, hipDeviceAttributeMultiprocessorCount, dev) != hipSuccess) { grid = -1; return; }
        if (hipFuncSetAttribute((const void*)fwd, hipFuncAttributeMaxDynamicSharedMemorySize, LDS_BYTES) != hipSuccess) { fprintf(stderr, "kernel_launch: hipFuncSetAttribute failed\n"); grid = -1; return; }
        if (hipOccupancyMaxActiveBlocksPerMultiprocessor(&per_cu, (const void*)fwd, NTHR, LDS_BYTES) != hipSuccess || per_cu < 1) { fprintf(stderr, "kernel_launch: occupancy query says %d\n", per_cu); }
        (void)hipGetLastError();
        grid = cus;
    }
    if (grid < 0) return;
    (void)in_sizes;
    if (hipMemsetAsync(d_ws, 0, CTL_BYTES, stream) != hipSuccess) return;
    Args a;
    for (int i = 0; i < 64; ++i) a.in[i] = (const float*)d_in[i];
    a.out = (float*)d_out; a.ws = (unsigned char*)d_ws;
    hipLaunchKernelGGL(fwd, dim3(grid), dim3(NTHR), LDS_BYTES, stream, a);
}
```

```cpp
#include <hip/hip_runtime.h>
#include <stdint.h>
#include <stdio.h>

#ifndef DIAG
#define DIAG 0
#endif

typedef unsigned short bf16_t;
typedef short bf16x8 __attribute__((ext_vector_type(8)));
typedef float f32x4 __attribute__((ext_vector_type(4)));
typedef float f32x2 __attribute__((ext_vector_type(2)));
typedef float f32x16 __attribute__((ext_vector_type(16)));
typedef unsigned u32x4 __attribute__((ext_vector_type(4)));
typedef unsigned u32x2 __attribute__((ext_vector_type(2)));
#define LAS __attribute__((address_space(3)))
#define GAS __attribute__((address_space(1)))
#define DEV __device__ __forceinline__

constexpr int NTOK = 32768, SEQ = 4096, NB = 8, DM = 1024;
constexpr int NTHR = 512, NWAVE = 8;
constexpr float DN_ALPHA = 1.681792830507429f;
constexpr float LN_EPS = 1e-5f;
constexpr float LOG2E = 1.4426950408889634f;
constexpr float QSCALE = 0.125f * LOG2E;

DEV unsigned cvt_pk_bf16(float lo, float hi) { unsigned r; asm volatile("v_cvt_pk_bf16_f32 %0, %1, %2" : "=v"(r) : "v"(lo), "v"(hi)); return r; }
DEV bf16_t f2bf(float x) { return (bf16_t)(cvt_pk_bf16(x, 0.f) & 0xffffu); }
DEV float bf2f(bf16_t b) { return __uint_as_float(((unsigned)b) << 16); }
DEV float bflo(unsigned w) { return __uint_as_float(w << 16); }
DEV float bfhi(unsigned w) { return __uint_as_float(w & 0xffff0000u); }
DEV float fast_exp2(float x) { return __builtin_amdgcn_exp2f(x); }
DEV float fast_rcp(float x) { return __builtin_amdgcn_rcpf(x); }
DEV float sigmoidf_(float x) { return fast_rcp(1.f + fast_exp2(-x * LOG2E)); }
DEV float siluf_(float x) { return x * sigmoidf_(x); }
DEV float gelu_tanh(float x) {
    const float u = 0.7978845608028654f * (x + 0.044715f * x * x * x);
    const float t = 1.f - 2.f * fast_rcp(1.f + fast_exp2(2.f * LOG2E * u));
    return 0.5f * x * (1.f + t);
}
template <int X> DEV float swz_xor(float v) { return __int_as_float(__builtin_amdgcn_ds_swizzle(__float_as_int(v), 0x1F | (X << 10))); }
template <int X> DEV int swz_xor_i(int v) { return __builtin_amdgcn_ds_swizzle(v, 0x1F | (X << 10)); }
DEV float bperm_f(int srclane, float v) { return __int_as_float(__builtin_amdgcn_ds_bpermute(srclane << 2, __float_as_int(v))); }
DEV int bperm_i(int srclane, int v) { return __builtin_amdgcn_ds_bpermute(srclane << 2, v); }
DEV float xor32_f(float v, int lane) { return bperm_f(lane ^ 32, v); }
DEV float wave_sum(float v, int lane) {
    v += swz_xor<1>(v); v += swz_xor<2>(v); v += swz_xor<4>(v); v += swz_xor<8>(v); v += swz_xor<16>(v); v += xor32_f(v, lane);
    return v;
}

#define XB_TMO      128
#define XB_XCNT(j)  (256  + 64 * (j))
#define XB_XSUB(j)  (1280 + 64 * (j))
#define XB_XGEN(j)  (2304 + 64 * (j))
#define XB_TOP      3328
#define XB_TOPGEN   3392
#define XCD_BAR_WORDS 3456
#define XB_SPIN_CAP (1u << 18)

__device__ __forceinline__ unsigned xb_ld(unsigned* p)              { return __hip_atomic_load(p, __ATOMIC_RELAXED, __HIP_MEMORY_SCOPE_AGENT); }
__device__ __forceinline__ unsigned xb_add(unsigned* p, unsigned v) { return __hip_atomic_fetch_add(p, v, __ATOMIC_RELAXED, __HIP_MEMORY_SCOPE_AGENT); }
__device__ __forceinline__ unsigned xb_xcc_id() { return (unsigned)__builtin_amdgcn_s_getreg((3 << 11) | 20) & 0xFu; }
#define XB_SPIN(cond, bar) do { unsigned _sp = 0; while (cond) { __builtin_amdgcn_s_sleep(1); \
    if ((++_sp & 255u) == 0u) { if (xb_ld(&(bar)[XB_TMO])) break; if (_sp > XB_SPIN_CAP) { atomicAdd(&(bar)[XB_TMO], 1u); break; } } } } while (0)

struct XcdBarrier { unsigned* bar; unsigned x; volatile LAS unsigned* st; };

__device__ __forceinline__ XcdBarrier xcd_barrier_post(unsigned* bar, volatile LAS unsigned* st) {
    XcdBarrier b; b.bar = bar; b.x = xb_xcc_id(); b.st = st;
    if (threadIdx.x == 0) (void)xb_add(&bar[XB_XCNT(b.x)], 1u);
    return b;
}
__device__ __forceinline__ void xcd_barrier_complete(unsigned* bar, unsigned x, unsigned& nloc, unsigned& nx) {
    const unsigned G = gridDim.x * gridDim.y * gridDim.z;
    unsigned sum, cnt, mine, sp = 0u;
    for (;;) {
        sum = 0u; cnt = 0u; mine = 0u;
#pragma unroll
        for (unsigned j = 0; j < 16; ++j) { const unsigned c = xb_ld(&bar[XB_XCNT(j)]); sum += c; cnt += (c > 0u) ? 1u : 0u; mine = (j == x) ? c : mine; }
        if (sum == G) break;
        __builtin_amdgcn_s_sleep(1);
        if ((++sp & 255u) == 0u) { if (xb_ld(&bar[XB_TMO])) break; if (sp > XB_SPIN_CAP) { atomicAdd(&bar[XB_TMO], 1u); break; } }
    }
    nloc = mine > 0u ? mine : 1u; nx = cnt > 0u ? cnt : 1u;
}
__device__ __forceinline__ void xcd_barrier(const XcdBarrier& b) {
    asm volatile("s_waitcnt vmcnt(0)" ::: "memory");
    __syncthreads();
    if (threadIdx.x == 0) {
        unsigned* bar = b.bar;
        __builtin_amdgcn_s_waitcnt(0);
        unsigned nloc = b.st[0], nx = b.st[1];
        if (nloc == 0u) { xcd_barrier_complete(bar, b.x, nloc, nx); b.st[0] = nloc; b.st[1] = nx; }
        const unsigned old = xb_add(&bar[XB_XSUB(b.x)], 1u);
        const unsigned gen = old / nloc;
        if (old + 1u == (gen + 1u) * nloc) {
            __builtin_amdgcn_fence(__ATOMIC_RELEASE, "agent");
            asm volatile("s_waitcnt vmcnt(0)" ::: "memory");
            const unsigned og = xb_add(&bar[XB_TOP], 1u);
            const unsigned tg = og / nx;
            if (og + 1u == (tg + 1u) * nx) xb_add(&bar[XB_TOPGEN], 1u);
            else XB_SPIN(xb_ld(&bar[XB_TOPGEN]) == tg, bar);
            __builtin_amdgcn_fence(__ATOMIC_ACQUIRE, "agent");
            xb_add(&bar[XB_XGEN(b.x)], 1u);
            asm volatile("s_waitcnt vmcnt(0)" ::: "memory");
        } else {
            XB_SPIN(xb_ld(&bar[XB_XGEN(b.x)]) == gen, bar);
            __builtin_amdgcn_fence(__ATOMIC_ACQUIRE, "agent");
            asm volatile("s_waitcnt vmcnt(0)" ::: "memory");
        }
    }
    __syncthreads();
}

constexpr size_t MB = 1024ull * 1024ull;
constexpr size_t WS_CTL = 0;
constexpr int    CW_BAR = 0;
constexpr int    CW_DIAG = 4096;
constexpr size_t CTL_BYTES = 64 * 1024;
constexpr size_t WS_ROPE = 64 * 1024;
constexpr size_t WS_META = WS_ROPE + 256 * 1024;
constexpr int    META_CNT = 0, META_SEG = 256 * 64, META_NMT = META_SEG + 80, META_TILE = META_NMT + 16;
constexpr size_t WS_BIAS = WS_META + 128 * 1024;
constexpr size_t WS_XB = 1 * MB;
constexpr size_t XB_BYTES = (size_t)(NTOK + 256) * DM * 2;
constexpr size_t WS_WMIX = WS_XB + ((XB_BYTES + MB - 1) / MB) * MB;
constexpr size_t WMIX_BYTES = 24 * MB;
constexpr size_t WS_WMOE = WS_WMIX + WMIX_BYTES;
constexpr size_t WE1_ELEMS = (size_t)65 * 512 * 1024;
constexpr size_t WE2_ELEMS = (size_t)65 * 1024 * 256;
constexpr size_t WS_WE1 = WS_WMOE, WS_WE2 = WS_WE1 + WE1_ELEMS * 2, WS_WR = WS_WE2 + WE2_ELEMS * 2;
constexpr size_t WMOE_BYTES = ((WE1_ELEMS + WE2_ELEMS) * 2 + 64 * 1024 * 2 + MB - 1) / MB * MB;
constexpr size_t WS_ACT = WS_WMOE + WMOE_BYTES;

constexpr int    MOE_ROWS_R = 262144 + 64 * 256;
constexpr int    MOE_ROWS = MOE_ROWS_R + NTOK;
constexpr size_t A_PE = WS_ACT, A_PG = A_PE + 1 * MB, A_PR = A_PG + 1 * MB, A_POS = A_PR + 1 * MB;
constexpr size_t A_ROWTOK = A_POS + 1 * MB, A_ROWGATE = A_ROWTOK + 2 * MB;
constexpr size_t A_H = A_ROWGATE + 2 * MB;
constexpr size_t A_Y = A_H + ((size_t)MOE_ROWS * 256 * 2 + MB - 1) / MB * MB;
constexpr size_t MOE_END = A_Y + (size_t)MOE_ROWS_R * 1024 * 2;
constexpr size_t N_Q = WS_ACT;
constexpr size_t N_KCVC = N_Q + 64 * MB;
constexpr size_t N_KS = N_KCVC + 32 * MB, N_KW = N_KS + 16 * MB;
constexpr size_t N_VTS = N_KW + 16 * MB, N_VTW = N_VTS + 16 * MB;
constexpr size_t N_GATE = N_VTW + 16 * MB;
constexpr size_t N_HC = N_GATE + 8 * MB;
constexpr size_t N_KCMP = N_HC + 8 * MB;
constexpr size_t N_VCMPT = N_KCMP + 1 * MB;
constexpr size_t N_O = N_VCMPT + 1 * MB;
constexpr size_t NSA_END = N_O + 64 * MB;
constexpr size_t G_Q = WS_ACT, G_K = G_Q + 32 * MB;
constexpr size_t G_R = G_K + 32 * MB;
constexpr size_t G_ALR = G_R + 64 * MB;
constexpr size_t G_VT = G_ALR + 2 * MB;
constexpr size_t G_OI = G_VT + 64 * MB;
constexpr size_t G_QG = G_OI + 128 * MB;
constexpr size_t G_DST = G_QG + 32 * MB;
constexpr size_t G_DEC = G_DST + 128 * MB;
constexpr size_t G_O = G_DEC + 1 * MB;
constexpr size_t GLA_END = G_O + 64 * MB;
constexpr size_t D_Q = WS_ACT, D_K = D_Q + 192 * MB;
constexpr size_t D_VT = D_K + 192 * MB;
constexpr size_t D_OG = D_VT + 192 * MB;
constexpr size_t D_LSE = D_OG + 192 * MB;
constexpr size_t D_O = D_Q;
constexpr size_t DIL_END = D_LSE + 6 * MB;
constexpr size_t WS_NEED = (MOE_END > DIL_END ? MOE_END : DIL_END) > (NSA_END > GLA_END ? NSA_END : GLA_END) ? (MOE_END > DIL_END ? MOE_END : DIL_END) : (NSA_END > GLA_END ? NSA_END : GLA_END);

constexpr size_t NW_A = 0, NW_V = NW_A + (size_t)2304 * 1024, NW_W1 = NW_V + (size_t)512 * 1024, NW_OUT = NW_W1 + (size_t)2 * 256 * 2048, NW_W2 = NW_OUT + (size_t)1024 * 1024;
constexpr size_t GW_A = 0, GW_V = GW_A + (size_t)2304 * 1024, GW_OUT = GW_V + (size_t)1024 * 1024;
constexpr size_t DW_A = 0, DW_V = DW_A + (size_t)6144 * 1024, DW_OUT = DW_V + (size_t)3072 * 1024;
static_assert((DW_OUT + 1024 * 1024) * 2 <= WMIX_BYTES, "WMIX too small");

constexpr int LDS_MAIN = 131072;
constexpr int LDS_MISC = LDS_MAIN;
constexpr int LDS_DESC = LDS_MISC + 1024;
constexpr int LDS_BYTES = LDS_MAIN + 1024 + 16 * 192;

struct Args { const float* in[64]; float* out; unsigned char* ws; };

struct Ctx {
    LAS unsigned char* lds;
    unsigned char* ws;
    float* xf;
    int tid, lane, wave, G, vcu;
    DEV const float* in(int i) const { return (const float*)(GAS const float*)(((const unsigned long long LAS*)(lds + LDS_MISC + 64))[i]); }
    template <class T> DEV T* w(size_t off) const { return (T*)(ws + off); }
};
DEV unsigned long long uni64(unsigned long long v) {
    const unsigned lo = __builtin_amdgcn_readfirstlane((unsigned)v), hi = __builtin_amdgcn_readfirstlane((unsigned)(v >> 32));
    return ((unsigned long long)hi << 32) | lo;
}
DEV int uni(int v) { return __builtin_amdgcn_readfirstlane(v); }
template <class T> DEV T* unip(T* p) { return (T*)(GAS T*)uni64((unsigned long long)p); }
DEV Ctx make_ctx() {
    extern __shared__ __attribute__((aligned(16))) unsigned char lds_raw[];
    Ctx c;
    { unsigned lb = 0u; asm volatile("" : "+s"(lb)); c.lds = (LAS unsigned char*)lds_raw + lb; }
    {
        unsigned long long w = uni64((unsigned long long)*(unsigned char* LAS*)(c.lds + LDS_MISC + 16)), o = uni64((unsigned long long)*(float* LAS*)(c.lds + LDS_MISC + 24));
        asm volatile("" : "+s"(w), "+s"(o));
        c.ws = (unsigned char*)(GAS unsigned char*)w; c.xf = (float*)(GAS float*)o;
    }
    int tz_ = threadIdx.x; asm volatile("" : "+v"(tz_));
    c.tid = tz_; c.lane = c.tid & 63; c.wave = uni(c.tid >> 6);
    { int g = gridDim.x, bx = blockIdx.x; asm volatile("" : "+s"(g), "+s"(bx)); c.G = g; c.vcu = (g % 8 == 0) ? (bx % 8) * (g / 8) + bx / 8 : bx; }
    return c;
}

struct ConvJob {
    const float* src; bf16_t* dst; int ldn, K, ntn, nvalid, nbatch; size_t sbatch, dbatch; int mode; int col0;
};
DEV int conv_srccol(const ConvJob& j, int nt) {
    const int n = nt * 64;
    switch (j.mode) {
    default: return j.col0 + n;
    case 1: { const int pn = n >> 8, half = (n >> 7) & 1, jj = n & 127; return half * 256 + pn * 128 + jj; }
    }
}
#define CONV_ISSUE(t_) do { const int b_ = (t_) / per, r_ = (t_) - b_ * per, nt_ = r_ / nkt, kt_ = r_ - nt_ * nkt; \
        const float* s_ = j.src + (size_t)b_ * j.sbatch + (size_t)(kt_ * 128) * j.ldn + conv_srccol(j, nt_); \
        const bool ok_ = nt_ * 64 + n4 < j.nvalid; \
        _Pragma("unroll") for (int i = 0; i < 2; ++i) _Pragma("unroll") for (int q = 0; q < 2; ++q) \
            v[i][q] = ok_ ? *(const f32x4*)(s_ + (size_t)(2 * kp + q + 64 * i) * j.ldn + n4) : (f32x4){0.f, 0.f, 0.f, 0.f}; } while (0)
DEV int conv_run(const ConvJob& j, int rot) {
    const Ctx c = make_ctx();
    LAS bf16_t* T = (LAS bf16_t*)c.lds;
    const int nkt = j.K >> 7, per = j.ntn * nkt, total = per * j.nbatch;
    const int n4 = (c.tid & 15) * 4, kp = c.tid >> 4;
    const int first = (c.vcu - (rot % c.G) + c.G) % c.G;
    f32x4 v[2][2];
    int par = 0;
    if (first < total) CONV_ISSUE(first);
    for (int t = first; t < total; t += c.G) {
        LAS bf16_t* Tb = T + par * (64 * 136);
#pragma unroll
        for (int i = 0; i < 2; ++i)
#pragma unroll
            for (int jj = 0; jj < 4; ++jj) *(LAS unsigned*)(Tb + (n4 + jj) * 136 + 2 * kp + 64 * i) = cvt_pk_bf16(v[i][0][jj], v[i][1][jj]);
        const int b = t / per, r = t - b * per, nt = r / nkt, kt = r - nt * nkt;
        if (t + c.G < total) CONV_ISSUE(t + c.G);
        __syncthreads();
#pragma unroll
        for (int q = 0; q < 2; ++q) {
            const int id = c.tid + 512 * q, n = id >> 4, cc = id & 15;
            const u32x4 o = *(const LAS u32x4*)(Tb + n * 136 + cc * 8);
            *(u32x4*)(j.dst + (size_t)b * j.dbatch + (size_t)(nt * 64 + n) * j.K + kt * 128 + cc * 8) = o;
        }
        par ^= 1;
    }
    __syncthreads();
    return rot + total;
}
DEV int conv(const float* src, int ldn, int col0, int nvalid, int nrows_pad, int K, bf16_t* dst, int rot) {
    ConvJob j; j.src = src; j.dst = dst; j.ldn = ldn; j.K = K; j.ntn = nrows_pad / 64; j.nvalid = nvalid; j.nbatch = 1; j.sbatch = 0; j.dbatch = 0; j.mode = 0; j.col0 = col0;
    return conv_run(j, rot);
}

DEV void conv_router(const float* rw, bf16_t* dst) {
    const Ctx c = make_ctx();
    for (int idx = c.vcu * NTHR + c.tid; idx < 64 * 1024; idx += c.G * NTHR) {
        const int k = idx >> 6, e = idx & 63;
        const int fq = e >> 4, q = e & 15, i = 16 * (q >> 2) + 4 * fq + (q & 3);
        dst[(size_t)i * 1024 + k] = f2bf(rw[idx]);
    }
}

DEV void sincos_d(double x, double& s, double& c) {
    const double k = rint(x * 0.6366197723675814);
    const double r = (x - k * 1.5707963267948966) - k * 6.123233995736766e-17;
    const double r2 = r * r;
    double sp = -7.647163731819816e-13; sp = sp * r2 + 1.605904383682161e-10; sp = sp * r2 - 2.505210838544172e-08; sp = sp * r2 + 2.755731922398589e-06;
    sp = sp * r2 - 1.984126984126984e-04; sp = sp * r2 + 8.333333333333333e-03; sp = sp * r2 - 1.666666666666667e-01; sp = r + r * r2 * sp;
    double cp = -1.147074559772972e-11; cp = cp * r2 + 2.087675698786810e-09; cp = cp * r2 - 2.755731922398589e-07; cp = cp * r2 + 2.480158730158730e-05;
    cp = cp * r2 - 1.388888888888889e-03; cp = cp * r2 + 4.166666666666666e-02; cp = cp * r2 - 0.5; cp = 1.0 + r2 * cp;
    const int q = ((int)k) & 3;
    s = (q == 0) ? sp : (q == 1) ? cp : (q == 2) ? -sp : -cp;
    c = (q == 0) ? cp : (q == 1) ? -sp : (q == 2) ? -cp : sp;
}
DEV void rope_table() {
    const Ctx c = make_ctx();
    float* ct = c.w<float>(WS_ROPE); float* st = ct + 4096 * 8;
    const float inv[8] = {1.0f, 0.19393656f, 0.037611387f, 0.0072942254f, 0.0014146171f, 0.00027434599f, 5.3205722e-05f, 1.0318535e-05f};
    for (int idx = c.vcu * NTHR + c.tid; idx < 4096 * 8; idx += c.G * NTHR) {
        const int pos = idx >> 3, i = idx & 7;
        float iv = inv[0];
#pragma unroll
        for (int q = 1; q < 8; ++q) iv = (i == q) ? inv[q] : iv;
        const float ang = (float)pos * iv;
        double s, co; sincos_d((double)ang, s, co);
        ct[idx] = (float)co; st[idx] = (float)s;
    }
}

DEV void prologue() {
    const Ctx c = make_ctx();
    const float* x = c.in(0);
    bf16_t* xb = c.w<bf16_t>(WS_XB);
    const size_t n4 = (size_t)NTOK * DM / 4;
    for (size_t i = (size_t)c.vcu * NTHR + c.tid; i < n4; i += (size_t)c.G * NTHR) {
        const f32x4 v = ((const f32x4*)x)[i];
        u32x2 o; o.x = cvt_pk_bf16(v[0], v[1]); o.y = cvt_pk_bf16(v[2], v[3]);
        ((u32x2*)xb)[i] = o;
    }
    for (int i = c.vcu * NTHR + c.tid; i < 256 * DM / 2; i += c.G * NTHR) ((unsigned*)(xb + (size_t)NTOK * DM))[i] = 0u;
    rope_table();
}

template <int MODE>
DEV void ln_phase(const float* g, const float* b, float* fout) {
    const Ctx c = make_ctx();
    bf16_t* xb = c.w<bf16_t>(WS_XB);
    const int* pos = c.w<int>(A_POS);
    const bf16_t* Y = c.w<bf16_t>(A_Y);
    f32x4 gv[4], bv[4];
#pragma unroll
    for (int j = 0; j < 4; ++j) { gv[j] = *(const f32x4*)(g + j * 256 + c.lane * 4); bv[j] = *(const f32x4*)(b + j * 256 + c.lane * 4); }
    for (int row = c.vcu * NWAVE + c.wave; row < NTOK; row += c.G * NWAVE) {
        bf16_t* xr = xb + (size_t)row * DM;
        f32x4 v[4];
#pragma unroll
        for (int j = 0; j < 4; ++j) { const u32x2 w = *(const u32x2*)(xr + j * 256 + c.lane * 4); v[j][0] = bflo(w.x); v[j][1] = bfhi(w.x); v[j][2] = bflo(w.y); v[j][3] = bfhi(w.y); }
        if (MODE == 1) {
            int p[8];
#pragma unroll
            for (int k = 0; k < 8; ++k) p[k] = pos[row * 8 + k];
#pragma unroll
            for (int k = 0; k < 8; ++k) {
                const bf16_t* yr = Y + (size_t)p[k] * DM;
#pragma unroll
                for (int j = 0; j < 4; ++j) {
                    const u32x2 w = *(const u32x2*)(yr + j * 256 + c.lane * 4);
                    v[j][0] += bflo(w.x); v[j][1] += bfhi(w.x); v[j][2] += bflo(w.y); v[j][3] += bfhi(w.y);
                }
            }
        }
        float s = 0.f;
#pragma unroll
        for (int j = 0; j < 4; ++j) s += (v[j][0] + v[j][1]) + (v[j][2] + v[j][3]);
        const float mu = wave_sum(s, c.lane) * (1.f / 1024.f);
        float q = 0.f;
#pragma unroll
        for (int j = 0; j < 4; ++j) { v[j] = v[j] - mu; q += (v[j][0] * v[j][0] + v[j][1] * v[j][1]) + (v[j][2] * v[j][2] + v[j][3] * v[j][3]); }
        const float rs = __builtin_amdgcn_rsqf(wave_sum(q, c.lane) * (1.f / 1024.f) + LN_EPS);
#pragma unroll
        for (int j = 0; j < 4; ++j) {
            const f32x4 o = v[j] * rs * gv[j] + bv[j];
            if (fout) *(f32x4*)(fout + (size_t)row * DM + j * 256 + c.lane * 4) = o;
            u32x2 w; w.x = cvt_pk_bf16(o[0], o[1]); w.y = cvt_pk_bf16(o[2], o[3]);
            *(u32x2*)(xr + j * 256 + c.lane * 4) = w;
        }
    }
}

constexpr int BM = 256, BK = 64, HALF = 128, HT = HALF * BK;

enum { EPI_NSA_A = 1, EPI_NSA_V, EPI_CMP1, EPI_WOUT, EPI_GLA_A, EPI_GLA_V, EPI_DIL_A, EPI_DIL_V, EPI_MOE1, EPI_MOE2 };
enum { AM_ID = 0, AM_IDX = 1, AM_CMP = 2 };
enum { BM_ID = 0, BM_DIL = 1, BM_EXP = 2 };

struct GemmDesc {
    const bf16_t* A; const bf16_t* Bt;
    int lda, ldb, K, kstepA;
    int nM, nN; const int* nM_ptr;
    int amode; const int* aidx;
    int bmode; const int* tile_e; size_t bstride;
    int epi;
    void* o0; void* o1; void* o2; void* o3;
    const float* f0; const float* f1;
};

#ifndef GEMM_LINKAGE
#define GEMM_LINKAGE __device__ __forceinline__
#endif
DEV GemmDesc load_desc(const Ctx& c, int slot) {
    const GemmDesc* s = (const GemmDesc*)(unsigned char*)(c.lds + LDS_DESC + slot * 192);
    GemmDesc d;
    d.A = unip(s->A); d.Bt = unip(s->Bt); d.lda = uni(s->lda); d.ldb = uni(s->ldb); d.K = uni(s->K); d.kstepA = uni(s->kstepA);
    d.nM = uni(s->nM); d.nN = uni(s->nN); d.nM_ptr = unip(s->nM_ptr); d.amode = uni(s->amode); d.aidx = unip(s->aidx);
    d.bmode = uni(s->bmode); d.tile_e = unip(s->tile_e); d.bstride = (size_t)uni64((unsigned long long)s->bstride); d.epi = uni(s->epi);
    d.o0 = unip(s->o0); d.o1 = unip(s->o1); d.o2 = unip(s->o2); d.o3 = unip(s->o3); d.f0 = unip(s->f0); d.f1 = unip(s->f1);
    return d;
}
DEV int lds_byte(int r, int c) { const int st = (r >> 4) * 2 + (c >> 5), rr = r & 15, cc = c & 31, ob = rr * 64 + cc * 2; return st * 1024 + (ob ^ (((ob >> 9) & 1) << 5)); }
DEV void stage_rc(int b, int& R, int& C) { const int st = b / 1024, sb = b % 1024, swz = sb ^ (((sb >> 9) & 1) << 5); R = (st >> 1) * 16 + swz / 64; C = (st & 1) * 32 + (swz % 64) / 2; }

DEV float rope_pair(float v, float partner, bool hi, float cs, float sn) {
    return hi ? (v * cs + partner * sn) : (v * cs - partner * sn);
}

DEV void stage_put(LAS unsigned char* lds, int lrow, int lcol, u32x2 w) {
    *(LAS u32x2*)(lds + lrow * 512 + (((lcol >> 3) ^ (lrow & 15)) << 4) + ((lcol & 4) << 1)) = w;
}
DEV u32x2 pk4(f32x4 v) { u32x2 w; w.x = cvt_pk_bf16(v[0], v[1]); w.y = cvt_pk_bf16(v[2], v[3]); return w; }
DEV int vt16_col(int lcol) { return (lcol & ~15) + 8 * ((lcol >> 2) & 1) + 4 * ((lcol >> 3) & 1); }

template <int EPI>
DEV void epi_quad(const Ctx& c, const GemmDesc& d, int row, int col, int lrow, int lcol, f32x4 v, int texp) {
    if (EPI == EPI_WOUT) {
        const u32x2 xw = *(const u32x2*)((const bf16_t*)d.o0 + (size_t)row * DM + col);
        f32x4 x; x[0] = bflo(xw.x); x[1] = bfhi(xw.x); x[2] = bflo(xw.y); x[3] = bfhi(xw.y);
        stage_put(c.lds, lrow, lcol, pk4(x * DN_ALPHA + v));
    } else if (EPI == EPI_NSA_A) {
        const bool roped = (col < 1280) || (col >= 1536 && col < 2048);
        const int hd = col & 63;
        if (roped) {
            f32x4 pv; pv[0] = xor32_f(v[0], c.lane); pv[1] = xor32_f(v[1], c.lane); pv[2] = xor32_f(v[2], c.lane); pv[3] = xor32_f(v[3], c.lane);
            if (hd < 16) {
                const int pos = row & (SEQ - 1); const float* ct = c.w<float>(WS_ROPE) + pos * 8 + (hd & 7); const float* st = ct + 4096 * 8;
                const f32x4 cs = *(const f32x4*)ct, sn = *(const f32x4*)st; const bool hi = hd >= 8;
#pragma unroll
                for (int j = 0; j < 4; ++j) v[j] = rope_pair(v[j], pv[j], hi, cs[j], sn[j]);
            }
        }
        if (col < 1024) stage_put(c.lds, lrow, lcol, pk4(v * QSCALE));
        else if (col < 2048) stage_put(c.lds, lrow, lcol, pk4(v));
        else if (col < 2048 + 48) {
            f32x4 g; g[0] = sigmoidf_(v[0]); g[1] = sigmoidf_(v[1]); g[2] = sigmoidf_(v[2]); g[3] = sigmoidf_(v[3]);
            *(f32x4*)((float*)d.o2 + (size_t)row * 48 + (col - 2048)) = g;
        }
    } else if (EPI == EPI_NSA_V || EPI == EPI_DIL_V) {
        stage_put(c.lds, lrow, vt16_col(lcol), pk4(v));
    } else if (EPI == EPI_CMP1) {
        const int which = row >> 13; const f32x4 bb = *(const f32x4*)(d.f0 + which * 256 + col);
        v = v + bb; f32x4 g; g[0] = gelu_tanh(v[0]); g[1] = gelu_tanh(v[1]); g[2] = gelu_tanh(v[2]); g[3] = gelu_tanh(v[3]);
        stage_put(c.lds, lrow, lcol, pk4(g));
    } else if (EPI == EPI_GLA_A) {
        if (col < 1024) stage_put(c.lds, lrow, lcol, pk4(v));
        else if (col < 2048) { f32x4 g; g[0] = siluf_(v[0]); g[1] = siluf_(v[1]); g[2] = siluf_(v[2]); g[3] = siluf_(v[3]); stage_put(c.lds, lrow, lcol, pk4(g)); }
        else if (col < 2048 + 16) *(f32x4*)((float*)d.o2 + (size_t)row * 16 + (col - 2048)) = v;
    } else if (EPI == EPI_GLA_V) {
        stage_put(c.lds, lrow, lcol, pk4(v));
    } else if (EPI == EPI_DIL_A) {
        const int hd = col & 63;
        f32x4 pv; pv[0] = xor32_f(v[0], c.lane); pv[1] = xor32_f(v[1], c.lane); pv[2] = xor32_f(v[2], c.lane); pv[3] = xor32_f(v[3], c.lane);
        if (hd < 16) {
            const int pos = row & (SEQ - 1); const float* ct = c.w<float>(WS_ROPE) + pos * 8 + (hd & 7); const float* st = ct + 4096 * 8;
            const f32x4 cs = *(const f32x4*)ct, sn = *(const f32x4*)st; const bool hi = hd >= 8;
#pragma unroll
            for (int j = 0; j < 4; ++j) v[j] = rope_pair(v[j], pv[j], hi, cs[j], sn[j]);
        }
        if (((col >> 10) & 1) == 0) v = v * QSCALE;
        stage_put(c.lds, lrow, lcol, pk4(v));
    } else if (EPI == EPI_MOE2) {
        const int e = texp;
        if (e == 64) {
            const int tok = ((const int*)d.o2)[row];
            const u32x2 xw = *(const u32x2*)((const bf16_t*)d.o1 + (size_t)tok * DM + col);
            f32x4 x; x[0] = bflo(xw.x); x[1] = bfhi(xw.x); x[2] = bflo(xw.y); x[3] = bfhi(xw.y);
            stage_put(c.lds, lrow, lcol, pk4(x * DN_ALPHA + v));
        } else stage_put(c.lds, lrow, lcol, pk4(v * d.f0[row]));
    }
    (void)texp; (void)lrow; (void)lcol;
}

template <int EPI>
DEV bf16_t* epi_rowptr(const GemmDesc& d, int grow, int pn, int bcol, int texp) {
    if (EPI == EPI_NSA_A) { if (pn < 4) return (bf16_t*)d.o0 + (size_t)grow * 1024 + pn * 256; if (pn < 8) return (bf16_t*)d.o1 + (size_t)(pn - 4) * NTOK * 256 + (size_t)grow * 256; return nullptr; }
    if (EPI == EPI_NSA_V) { const int vb = grow >> 8, kvh = (grow >> 6) & 3, dd = grow & 63, b = bcol >> 12, s0 = bcol & 4095;
        return (bf16_t*)d.o0 + (size_t)vb * (8u * 4u * 64u * 4096u) + ((size_t)((b * 4 + kvh) * 64 + dd)) * 4096 + s0; }
    if (EPI == EPI_CMP1) return (bf16_t*)d.o0 + (size_t)grow * 256;
    if (EPI == EPI_GLA_A) { if (pn < 4) return (bf16_t*)d.o0 + (size_t)(pn >> 1) * NTOK * 512 + (size_t)grow * 512 + (pn & 1) * 256; if (pn < 8) return (bf16_t*)d.o1 + (size_t)grow * 1024 + (pn - 4) * 256; return nullptr; }
    if (EPI == EPI_GLA_V) { const int b = bcol >> 12, s0 = bcol & 4095; return (bf16_t*)d.o0 + ((size_t)(b * 1024 + grow)) * 4096 + s0; }
    if (EPI == EPI_DIL_A) { const int g = pn >> 3, qk = (pn >> 2) & 1; return (bf16_t*)(qk ? d.o1 : d.o0) + (size_t)g * NTOK * 1024 + (size_t)grow * 1024 + (pn & 3) * 256; }
    if (EPI == EPI_DIL_V) { const int g = grow >> 10, hh = (grow >> 6) & 15, dd = grow & 63, b = bcol >> 12, j0 = bcol & 4095;
        return (bf16_t*)d.o0 + ((size_t)(((g * 8 + b) * 16 + hh) * 64 + dd)) * 4096 + j0; }
    if (EPI == EPI_MOE1) return (bf16_t*)d.o0 + (size_t)grow * 256 + pn * 128;
    if (EPI == EPI_MOE2) { if (texp == 64) return (bf16_t*)d.o1 + (size_t)((const int*)d.o2)[grow] * DM + pn * 256; return (bf16_t*)d.o0 + (size_t)grow * 1024 + pn * 256; }
    if (EPI == EPI_WOUT) return (bf16_t*)d.o0 + (size_t)grow * DM + pn * 256;
    return nullptr;
}
template <int EPI>
DEV void epi_writeout(const Ctx& c, const GemmDesc& d, int brow, int bcol, int pn, int texp) {
    constexpr int NCH = (EPI == EPI_MOE1) ? 16 : 32;
    __syncthreads();
    if (epi_rowptr<EPI>(d, brow, pn, bcol, texp) != nullptr) {
        const int q = c.tid & 31;
#pragma unroll 4
        for (int it = 0; it < 16; ++it) {
            const int lrow = it * 16 + (c.tid >> 5);
            if (q < NCH) {
                const u32x4 val = *(const LAS u32x4*)(c.lds + lrow * 512 + (q << 4));
                bf16_t* rp = epi_rowptr<EPI>(d, brow + lrow, pn, bcol, texp);
                *(u32x4*)(rp + ((q ^ (lrow & 15)) << 3)) = val;
            }
        }
    }
}

#define GSA(b, h) (((b) * 2 + (h)) * (HT * 2))
#define GSB(b, h) ((4 + (b) * 2 + (h)) * (HT * 2))
#define GLDS16(gp, lp) __builtin_amdgcn_global_load_lds((const unsigned*)(gp), (LAS unsigned*)(lp), 16, 0, 0)
#define STAGE(bufoff, g, voff) do { GLDS16((g) + (voff)[0], lds + (bufoff) + ldsw); GLDS16((g) + (voff)[1], lds + (bufoff) + ldsw + 8192); } while (0)
#define LDA(dst, b, h) _Pragma("unroll") for (int m = 0; m < 4; ++m) _Pragma("unroll") for (int k = 0; k < 2; ++k) \
    dst[m][k] = *(const LAS bf16x8*)(lds + GSA(b, h) + aoff + m * 2048 + k * 1024)
#define LDB(dst, b, h) _Pragma("unroll") for (int n = 0; n < 2; ++n) _Pragma("unroll") for (int k = 0; k < 2; ++k) \
    dst[n][k] = *(const LAS bf16x8*)(lds + GSB(b, h) + boff + n * 2048 + k * 1024)
#define MMA(ai, bj, At_, Bt_) do { __builtin_amdgcn_s_setprio(1); \
    _Pragma("unroll") for (int m = 0; m < 4; ++m) _Pragma("unroll") for (int n = 0; n < 2; ++n) _Pragma("unroll") for (int k = 0; k < 2; ++k) \
        acc[ai][bj][m][n] = __builtin_amdgcn_mfma_f32_16x16x32_bf16(Bt_[n][k], At_[m][k], acc[ai][bj][m][n], 0, 0, 0); \
    __builtin_amdgcn_s_setprio(0); } while (0)
#define WAIT_V(n) asm volatile("s_waitcnt vmcnt(" #n ")" ::: "memory")
#define WAIT_L(n) asm volatile("s_waitcnt lgkmcnt(" #n ")" ::: "memory")
#define BAR __builtin_amdgcn_s_barrier()
#define SCHED __builtin_amdgcn_sched_barrier(0)
#define EPI_LOOP(E) _Pragma("unroll") for (int ai = 0; ai < 2; ++ai) _Pragma("unroll") for (int bj = 0; bj < 2; ++bj) \
    _Pragma("unroll") for (int m = 0; m < 4; ++m) _Pragma("unroll") for (int n = 0; n < 2; ++n) \
        epi_quad<E>(c, d, brow + ai * HALF + wr * 64 + m * 16 + fr, bcol + bj * HALF + wc * 32 + n * 16 + fq * 4, ai * HALF + wr * 64 + m * 16 + fr, bj * HALF + wc * 32 + n * 16 + fq * 4, acc[ai][bj][m][n], texp)

GEMM_LINKAGE void gemm_phase(int slot) {
    const Ctx c = make_ctx();
    const GemmDesc d = load_desc(c, slot);
    LAS unsigned char* lds = c.lds;
    const int nM = d.nM_ptr ? uni(*d.nM_ptr) : d.nM;
    const int nN = d.nN, U = nM * nN, nt = d.K / BK;
    const size_t kstA = (size_t)d.kstepA * 2, kstB = (size_t)BK * 2;
    for (int u = c.vcu; u < U; u += c.G) {
        const int pm = u / nN, pn = u - pm * nN, brow = pm * BM, bcol = pn * BM;
        int tz = threadIdx.x; asm volatile("" : "+v"(tz));
        const int wid = uni(tz >> 6), wr = wid >> 2, wc = wid & 3;
        const unsigned ldsw = (unsigned)wid * 1024u;
        const int texp = (d.bmode == BM_EXP) ? uni(d.tile_e[pm]) : 0;
        const char* cA0; const char* cA1; const char* cB0; const char* cB1;
        unsigned voffA0[2], voffA1[2], voffB[2];
        {
            const char* Bb = (const char*)d.Bt;
            if (d.bmode == BM_EXP) Bb += (size_t)texp * d.bstride * 2;
            int sh = 0;
            if (d.bmode == BM_DIL) { sh = 2 * (pm >> 2); cB0 = Bb + (size_t)(bcol & ~4095) * d.ldb * 2; cB1 = cB0 + ((size_t)(128 << sh) * d.ldb) * 2; }
            else { cB0 = Bb + (size_t)bcol * d.ldb * 2; cB1 = cB0 + (size_t)HALF * d.ldb * 2; }
            if (d.amode == AM_CMP) { const int which = brow >> 13, bk = (brow & 8191) >> 8;
                cA0 = (const char*)d.A + ((size_t)which * (NTOK * 256) + (size_t)((bk >> 2) * SEQ) * 256 + (bk & 3) * 64) * 2; cA1 = cA0 + (size_t)HALF * d.lda * 2; }
            else if (d.amode == AM_IDX) { cA0 = (const char*)d.A; cA1 = cA0; }
            else { cA0 = (const char*)d.A + (size_t)brow * d.lda * 2; cA1 = cA0 + (size_t)HALF * d.lda * 2; }
#pragma unroll
            for (int i = 0; i < 2; ++i) {
                int R, C; stage_rc(tz * 16 + i * 8192, R, C);
                if (d.amode == AM_IDX) { voffA0[i] = (unsigned)(d.aidx[brow + R] * d.lda + C) * 2u; voffA1[i] = (unsigned)(d.aidx[brow + HALF + R] * d.lda + C) * 2u; }
                else { voffA0[i] = (unsigned)(R * d.lda + C) * 2u; voffA1[i] = voffA0[i]; }
                if (d.bmode == BM_DIL) { const int jx = (bcol & 4095) + R, rr = jx >> (12 - sh), uu = jx & ((4096 >> sh) - 1); voffB[i] = (unsigned)(((uu << sh) | rr) * d.ldb + C) * 2u; }
                else voffB[i] = (unsigned)(R * d.ldb + C) * 2u;
            }
        }
        asm volatile("s_waitcnt vmcnt(0)" ::: "memory");
        f32x4 acc[2][2][4][2];
#pragma unroll
        for (int ai = 0; ai < 2; ++ai)
#pragma unroll
            for (int bj = 0; bj < 2; ++bj)
#pragma unroll
                for (int m = 0; m < 4; ++m)
#pragma unroll
                    for (int n = 0; n < 2; ++n) acc[ai][bj][m][n] = (f32x4){0.f, 0.f, 0.f, 0.f};
        bf16x8 At[4][2], B0[2][2], B1[2][2];
        {
        const int lane = tz & 63, fr = lane & 15, fq = lane >> 4;
        const int aoff = lds_byte(wr * 64 + fr, fq * 8), boff = lds_byte(wc * 32 + fr, fq * 8);
        STAGE(GSB(0, 0), cB0, voffB); STAGE(GSA(0, 0), cA0, voffA0);
        STAGE(GSB(0, 1), cB1, voffB); STAGE(GSA(0, 1), cA1, voffA1);
        if (wr == 1) BAR;
        WAIT_V(4); BAR;
        STAGE(GSB(1, 0), cB0 + kstB, voffB); STAGE(GSA(1, 0), cA0 + kstA, voffA0); STAGE(GSB(1, 1), cB1 + kstB, voffB);
        WAIT_V(6); BAR;
        for (int t = 0; t < nt - 2; t += 2) {
            const char* a1 = cA1 + (size_t)(t + 1) * kstA;
            const char* a20 = cA0 + (size_t)(t + 2) * kstA; const char* a21 = cA1 + (size_t)(t + 2) * kstA;
            const char* b20 = cB0 + (size_t)(t + 2) * kstB; const char* b21 = cB1 + (size_t)(t + 2) * kstB;
            LDB(B0, 0, 0); SCHED; LDA(At, 0, 0); STAGE(GSA(1, 1), a1, voffA1);
            WAIT_L(8); BAR; WAIT_L(0); MMA(0, 0, At, B0); BAR; SCHED;
            LDB(B1, 0, 1); STAGE(GSB(0, 0), b20, voffB);
            BAR; WAIT_L(0); MMA(0, 1, At, B1); BAR;
            LDA(At, 0, 1); STAGE(GSA(0, 0), a20, voffA0);
            BAR; WAIT_L(0); MMA(1, 0, At, B0); BAR; SCHED;
            STAGE(GSB(0, 1), b21, voffB);
            WAIT_V(6); BAR; MMA(1, 1, At, B1); BAR;
            LDB(B0, 1, 0); SCHED; LDA(At, 1, 0); STAGE(GSA(0, 1), a21, voffA1);
            WAIT_L(8); BAR; WAIT_L(0); MMA(0, 0, At, B0); BAR; SCHED;
            LDB(B1, 1, 1); STAGE(GSB(1, 0), b20 + kstB, voffB);
            BAR; WAIT_L(0); MMA(0, 1, At, B1); BAR;
            LDA(At, 1, 1); STAGE(GSA(1, 0), a20 + kstA, voffA0);
            BAR; WAIT_L(0); MMA(1, 0, At, B0); BAR; SCHED;
            STAGE(GSB(1, 1), b21 + kstB, voffB);
            WAIT_V(6); BAR; MMA(1, 1, At, B1); BAR;
        }
        { LDB(B0, 0, 0); WAIT_V(0); LDA(At, 0, 0); STAGE(GSA(1, 1), cA1 + (size_t)(nt - 1) * kstA, voffA1);
          BAR; WAIT_L(0); MMA(0, 0, At, B0); BAR;
          LDB(B1, 0, 1); BAR; WAIT_L(0); MMA(0, 1, At, B1); BAR;
          LDA(At, 0, 1); WAIT_V(4); BAR; WAIT_L(0); MMA(1, 0, At, B0); MMA(1, 1, At, B1); BAR; }
        { LDB(B0, 1, 0); LDA(At, 1, 0); WAIT_V(2); BAR; WAIT_L(0); MMA(0, 0, At, B0); BAR;
          LDB(B1, 1, 1); WAIT_V(0); BAR; WAIT_L(0); MMA(0, 1, At, B1); BAR;
          LDA(At, 1, 1); BAR; WAIT_L(0); MMA(1, 0, At, B0); MMA(1, 1, At, B1); BAR; }
        if (wr == 0) BAR;
        }
        int ty = threadIdx.x; asm volatile("" : "+v"(ty));
        const int lane = ty & 63, fr = lane & 15, fq = lane >> 4;
        __syncthreads();
        switch (d.epi) {
        case EPI_WOUT:  EPI_LOOP(EPI_WOUT); epi_writeout<EPI_WOUT>(c, d, brow, bcol, pn, texp); break;
        case EPI_NSA_A: EPI_LOOP(EPI_NSA_A); epi_writeout<EPI_NSA_A>(c, d, brow, bcol, pn, texp); break;
        case EPI_NSA_V: EPI_LOOP(EPI_NSA_V); epi_writeout<EPI_NSA_V>(c, d, brow, bcol, pn, texp); break;
        case EPI_CMP1:  EPI_LOOP(EPI_CMP1); epi_writeout<EPI_CMP1>(c, d, brow, bcol, pn, texp); break;
        case EPI_GLA_A: EPI_LOOP(EPI_GLA_A); epi_writeout<EPI_GLA_A>(c, d, brow, bcol, pn, texp); break;
        case EPI_GLA_V: EPI_LOOP(EPI_GLA_V); epi_writeout<EPI_GLA_V>(c, d, brow, bcol, pn, texp); break;
        case EPI_DIL_A: EPI_LOOP(EPI_DIL_A); epi_writeout<EPI_DIL_A>(c, d, brow, bcol, pn, texp); break;
        case EPI_DIL_V: EPI_LOOP(EPI_DIL_V); epi_writeout<EPI_DIL_V>(c, d, brow, bcol, pn, texp); break;
        case EPI_MOE2:  EPI_LOOP(EPI_MOE2); epi_writeout<EPI_MOE2>(c, d, brow, bcol, pn, texp); break;
        case EPI_MOE1: {
#pragma unroll
            for (int ai = 0; ai < 2; ++ai)
#pragma unroll
                for (int m = 0; m < 4; ++m)
#pragma unroll
                    for (int n = 0; n < 2; ++n) {
                        const f32x4 g = acc[ai][0][m][n], uu = acc[ai][1][m][n];
                        u32x2 w; w.x = cvt_pk_bf16(siluf_(g[0]) * uu[0], siluf_(g[1]) * uu[1]); w.y = cvt_pk_bf16(siluf_(g[2]) * uu[2], siluf_(g[3]) * uu[3]);
                        stage_put(c.lds, ai * HALF + wr * 64 + m * 16 + fr, wc * 32 + n * 16 + fq * 4, w);
                    }
            epi_writeout<EPI_MOE1>(c, d, brow, bcol, pn, texp);
        } break;
        default: break;
        }
        asm volatile("s_waitcnt vmcnt(0)" ::: "memory");
        __syncthreads();
    }
}

DEV void route_a(const float* rb) {
    const Ctx c = make_ctx();
    const bf16_t* xb = c.w<bf16_t>(WS_XB);
    const bf16_t* rwt = c.w<bf16_t>(WS_WR);
    int* PE = c.w<int>(A_PE); float* PG = c.w<float>(A_PG); int* PR = c.w<int>(A_PR);
    int* CNT = c.w<int>(WS_META) + META_CNT;
    LAS int* el = (LAS int*)c.lds;
    LAS int* lr = el + 1024;
    const int fr = c.lane & 15, fq = c.lane >> 4;
    for (int unit = c.vcu; unit < NTOK / 128; unit += c.G) {
        const int tok0 = unit * 128 + c.wave * 16;
        f32x4 acc[4];
#pragma unroll
        for (int nt = 0; nt < 4; ++nt) acc[nt] = (f32x4){0.f, 0.f, 0.f, 0.f};
        const bf16_t* xr = xb + (size_t)(tok0 + fr) * DM + fq * 8;
        const bf16_t* wr_ = rwt + (size_t)fr * DM + fq * 8;
#pragma unroll 4
        for (int ks = 0; ks < 32; ++ks) {
            const bf16x8 bx = *(const bf16x8*)(xr + ks * 32);
#pragma unroll
            for (int nt = 0; nt < 4; ++nt) {
                const bf16x8 aw = *(const bf16x8*)(wr_ + (size_t)nt * 16 * DM + ks * 32);
                acc[nt] = __builtin_amdgcn_mfma_f32_16x16x32_bf16(aw, bx, acc[nt], 0, 0, 0);
            }
        }
        float s[16], sb[16];
#pragma unroll
        for (int q = 0; q < 16; ++q) { s[q] = sigmoidf_(acc[q >> 2][q & 3]); sb[q] = s[q] + rb[16 * fq + q]; }
        float gs[2];
#pragma unroll
        for (int hh = 0; hh < 2; ++hh) {
            float m1 = -3.0e38f, m2 = -3.0e38f;
#pragma unroll
            for (int q = 0; q < 8; ++q) { const float v = sb[8 * hh + q]; const bool gt = v > m1; m2 = gt ? m1 : fmaxf(m2, v); m1 = gt ? v : m1; }
            gs[hh] = m1 + m2;
        }
        float ga[8];
#pragma unroll
        for (int f2 = 0; f2 < 4; ++f2) { ga[2 * f2] = bperm_f(fr + 16 * f2, gs[0]); ga[2 * f2 + 1] = bperm_f(fr + 16 * f2, gs[1]); }
        bool gsel[2];
#pragma unroll
        for (int hh = 0; hh < 2; ++hh) {
            const int gi = 2 * fq + hh; const float mine = gs[hh]; int cnt = 0;
#pragma unroll
            for (int gj = 0; gj < 8; ++gj) cnt += (ga[gj] > mine || (ga[gj] == mine && gj < gi)) ? 1 : 0;
            gsel[hh] = cnt < 4;
        }
        float val[16];
#pragma unroll
        for (int q = 0; q < 16; ++q) val[q] = gsel[q >> 3] ? sb[q] : -3.0e38f;
        int ek[8]; float sk[8]; float ssum = 0.f;
#pragma unroll
        for (int k = 0; k < 8; ++k) {
            float bv = val[0], bs = s[0]; int bq = 0;
#pragma unroll
            for (int q = 1; q < 16; ++q) { const bool gt = val[q] > bv; bv = gt ? val[q] : bv; bs = gt ? s[q] : bs; bq = gt ? q : bq; }
            int be = 16 * fq + bq;
#pragma unroll
            for (int o = 16; o <= 32; o <<= 1) {
                const float ov = bperm_f(c.lane ^ o, bv), os = bperm_f(c.lane ^ o, bs); const int oe = bperm_i(c.lane ^ o, be);
                const bool take = (ov > bv) || (ov == bv && oe < be);
                bv = take ? ov : bv; bs = take ? os : bs; be = take ? oe : be;
            }
            ek[k] = be; sk[k] = bs; ssum += bs;
            const bool mine = (be >> 4) == fq; const int mq = be & 15;
#pragma unroll
            for (int q = 0; q < 16; ++q) val[q] = (mine && q == mq) ? -3.3e38f : val[q];
        }
        const float gsc = 2.5f / ssum;
        if (fq == 0) {
            const int tl = c.wave * 16 + fr, tg = tok0 + fr;
#pragma unroll
            for (int k = 0; k < 8; ++k) { el[tl * 8 + k] = ek[k]; PE[tg * 8 + k] = ek[k]; PG[tg * 8 + k] = sk[k] * gsc; }
        }
        __syncthreads();
        {
            LAS int* wc = lr + 1024;
            int cnt = 0;
            for (int p = c.wave * 128; p < c.wave * 128 + 128; ++p) { const int e = el[p]; if (e == c.lane) { lr[p] = cnt; ++cnt; } }
            wc[c.wave * 64 + c.lane] = cnt;
            __syncthreads();
            for (int p = c.tid; p < 1024; p += NTHR) { const int e = el[p], w = p >> 7; int off = 0; for (int q = 0; q < w; ++q) off += wc[q * 64 + e]; lr[p] += off; }
            if (c.tid < 64) { int t = 0; for (int q = 0; q < 8; ++q) t += wc[q * 64 + c.tid]; CNT[unit * 64 + c.tid] = t; }
        }
        __syncthreads();
        PR[unit * 1024 + c.tid] = lr[c.tid]; PR[unit * 1024 + 512 + c.tid] = lr[512 + c.tid];
        __syncthreads();
    }
}

DEV void route_b() {
    const Ctx c = make_ctx();
    const int* PE = c.w<int>(A_PE); const float* PG = c.w<float>(A_PG); const int* PR = c.w<int>(A_PR);
    int* POS = c.w<int>(A_POS); int* ROWTOK = c.w<int>(A_ROWTOK); float* ROWGATE = c.w<float>(A_ROWGATE);
    int* meta = c.w<int>(WS_META); const int* CNT = meta + META_CNT;
    LAS int* tot = (LAS int*)c.lds; LAS int* bef = tot + 64; LAS int* seg = bef + 64;
    const int nunit = NTOK / 128;
    for (int unit = c.vcu; unit < nunit; unit += c.G) {
        if (c.tid < 64) {
            int t = 0, b = 0;
            for (int u2 = 0; u2 < nunit; ++u2) { const int v = CNT[u2 * 64 + c.tid]; b += (u2 < unit) ? v : 0; t += v; }
            tot[c.tid] = t; bef[c.tid] = b;
        }
        __syncthreads();
        if (c.tid == 0) { int sg = 0; for (int e = 0; e < 64; ++e) { seg[e] = sg; sg += (tot[e] + 255) & ~255; } seg[64] = sg; }
        __syncthreads();
        const int P0 = seg[64];
        for (int p = c.tid; p < 1024; p += NTHR) {
            const int tok = unit * 128 + (p >> 3), gi = tok * 8 + (p & 7);
            const int e = PE[gi], dest = seg[e] + bef[e] + PR[unit * 1024 + p];
            POS[gi] = dest; ROWTOK[dest] = tok; ROWGATE[dest] = PG[gi];
        }
        if (unit < 64) {
            const int e = unit, lo = seg[e] + tot[e], hi = seg[e + 1];
            for (int r = lo + c.tid; r < hi; r += NTHR) { ROWTOK[r] = NTOK; ROWGATE[r] = 0.f; }
        }
        if (c.tid < 128) { const int r = P0 + unit * 128 + c.tid; ROWTOK[r] = unit * 128 + c.tid; ROWGATE[r] = 1.f; }
        if (unit == 0) {
            if (c.tid < 64) { for (int mt = seg[c.tid] >> 8; mt < (seg[c.tid + 1] >> 8); ++mt) meta[META_TILE + mt] = c.tid; }
            if (c.tid < 128) meta[META_TILE + (P0 >> 8) + c.tid] = 64;
            if (c.tid == 0) meta[META_NMT] = (P0 >> 8) + NTOK / 256;
        }
        __syncthreads();
    }
}

#define NEG_INF_F (-__builtin_inff())
struct FlashState { f32x16 o0, o1; float m, l; };
DEV void flash_init(FlashState& st) {
#pragma unroll
    for (int i = 0; i < 16; ++i) { st.o0[i] = 0.f; st.o1[i] = 0.f; }
    st.m = NEG_INF_F; st.l = 0.f;
}
DEV bf16x8 pack8(const f32x16& p, int base) {
    u32x4 w; w.x = cvt_pk_bf16(p[base + 0], p[base + 1]); w.y = cvt_pk_bf16(p[base + 2], p[base + 3]);
    w.z = cvt_pk_bf16(p[base + 4], p[base + 5]); w.w = cvt_pk_bf16(p[base + 6], p[base + 7]);
    return __builtin_bit_cast(bf16x8, w);
}
DEV f32x16 qk_tile(const bf16x8 (&kf)[4], const bf16x8 (&qf)[4]) {
    f32x16 S;
#pragma unroll
    for (int i = 0; i < 16; ++i) S[i] = 0.f;
#pragma unroll
    for (int s = 0; s < 4; ++s) S = __builtin_amdgcn_mfma_f32_32x32x16_bf16(kf[s], qf[s], S, 0, 0, 0);
    return S;
}
struct Mask { int base, span; };
DEV Mask mk_mask(int key0, int h, int klo, int khi, bool any) { Mask m; const bool ok = any && khi >= klo; m.base = ok ? key0 + 4 * h - klo : 0x40000000; m.span = ok ? khi - klo : 0; return m; }
DEV bool mask_ok(const Mask& m, int i) { return (unsigned)(m.base + (i & 3) + 8 * (i >> 2)) <= (unsigned)m.span; }
DEV void flash_tile(FlashState& st, f32x16 S, const bf16x8 (&vf)[4], bool need_mask, Mask mk, int lane) {
    if (need_mask) {
#pragma unroll
        for (int i = 0; i < 16; ++i) S[i] = mask_ok(mk, i) ? S[i] : NEG_INF_F;
    }
    float mx = S[0];
#pragma unroll
    for (int i = 1; i < 16; ++i) mx = fmaxf(mx, S[i]);
    mx = fmaxf(mx, xor32_f(mx, lane));
    const float mn = fmaxf(st.m, mx);
    const float mu = (mn == NEG_INF_F) ? 0.f : mn;
    const float alpha = fast_exp2(st.m - mu);
    float ls = 0.f;
#pragma unroll
    for (int i = 0; i < 16; ++i) { S[i] = fast_exp2(S[i] - mu); ls += S[i]; }
    st.l = st.l * alpha + ls; st.m = mn;
    if (__builtin_amdgcn_ballot_w64(alpha != 1.f) != 0ull) {
#pragma unroll
        for (int i = 0; i < 16; ++i) { st.o0[i] *= alpha; st.o1[i] *= alpha; }
    }
    const bf16x8 p0 = pack8(S, 0), p1 = pack8(S, 8);
    st.o0 = __builtin_amdgcn_mfma_f32_32x32x16_bf16(vf[0], p0, st.o0, 0, 0, 0);
    st.o0 = __builtin_amdgcn_mfma_f32_32x32x16_bf16(vf[1], p1, st.o0, 0, 0, 0);
    st.o1 = __builtin_amdgcn_mfma_f32_32x32x16_bf16(vf[2], p0, st.o1, 0, 0, 0);
    st.o1 = __builtin_amdgcn_mfma_f32_32x32x16_bf16(vf[3], p1, st.o1, 0, 0, 0);
}
DEV int key_of(int key0, int i, int h) { return key0 + (i & 3) + 8 * (i >> 2) + 4 * h; }

template <class P>
DEV void flash_load(const P& pol, int tile, int r, int h, bf16x8 (&kf)[4], bf16x8 (&vf)[4]) {
    const bf16_t* kp = pol.kptr(tile * 32 + r) + 8 * h;
#pragma unroll
    for (int s = 0; s < 4; ++s) kf[s] = *(const bf16x8*)(kp + 16 * s);
    const bf16_t* v0 = pol.vptr(r) + tile * 32 + 8 * h;
    const bf16_t* v1 = pol.vptr(32 + r) + tile * 32 + 8 * h;
    vf[0] = *(const bf16x8*)(v0); vf[1] = *(const bf16x8*)(v0 + 16); vf[2] = *(const bf16x8*)(v1); vf[3] = *(const bf16x8*)(v1 + 16);
}
template <class P>
DEV void flash_run(const P& pol, const bf16x8 (&qf)[4], FlashState& st, int t0, int t1, int r, int h) {
    int t = t0;
    while (t < t1 && pol.skip(t)) ++t;
    if (t >= t1) return;
    bf16x8 ka[4], va[4], kb[4], vb[4];
    flash_load(pol, t, r, h, ka, va);
    for (;;) {
        int tn = t + 1;
        while (tn < t1 && pol.skip(tn)) ++tn;
        if (tn < t1) flash_load(pol, tn, r, h, kb, vb);
        { const f32x16 S = qk_tile(ka, qf); const bool nm = pol.need_mask(t); flash_tile(st, S, va, nm, pol.mask(t * 32), 32 * h + r); }
        if (tn >= t1) break;
        t = tn; tn = t + 1;
        while (tn < t1 && pol.skip(tn)) ++tn;
        if (tn < t1) flash_load(pol, tn, r, h, ka, va);
        { const f32x16 S = qk_tile(kb, qf); const bool nm = pol.need_mask(t); flash_tile(st, S, vb, nm, pol.mask(t * 32), 32 * h + r); }
        if (tn >= t1) break;
        t = tn;
    }
}
template <bool FIRST>
DEV void flash_accum(const FlashState& st, float gate, LAS float* ot, int lane) {
    const float lt = st.l + xor32_f(st.l, lane);
    const float sc = lt > 0.f ? gate * fast_rcp(lt) : 0.f;
#pragma unroll
    for (int i = 0; i < 16; ++i) {
        if (FIRST) { ot[i * 64 + lane] = st.o0[i] * sc; ot[(16 + i) * 64 + lane] = st.o1[i] * sc; }
        else { ot[i * 64 + lane] += st.o0[i] * sc; ot[(16 + i) * 64 + lane] += st.o1[i] * sc; }
    }
}
DEV void store_o(bf16_t* dst, const f32x16& t0, const f32x16& t1, int h) {
#pragma unroll
    for (int a = 0; a < 4; ++a) {
        u32x2 w; w.x = cvt_pk_bf16(t0[4 * a], t0[4 * a + 1]); w.y = cvt_pk_bf16(t0[4 * a + 2], t0[4 * a + 3]);
        *(u32x2*)(dst + 8 * a + 4 * h) = w;
        u32x2 x; x.x = cvt_pk_bf16(t1[4 * a], t1[4 * a + 1]); x.y = cvt_pk_bf16(t1[4 * a + 2], t1[4 * a + 3]);
        *(u32x2*)(dst + 32 + 8 * a + 4 * h) = x;
    }
}

struct PolCmp {
    const bf16_t* kb; const bf16_t* vb; int t, t0, h;
    DEV const bf16_t* kptr(int key) const { return kb + (size_t)min(key, 255) * 64; }
    DEV const bf16_t* vptr(int d) const { return vb + (size_t)d * 256; }
    DEV bool skip(int) const { return false; }
    DEV bool need_mask(int tile) const { return 16 * (tile * 32 + 31) + 31 > t0; }
    DEV Mask mask(int key0) const { return mk_mask(key0, h, 0, (t - 31) >> 4, t >= 31); }
};
struct PolSel {
    const bf16_t* kb; const bf16_t* vb; int t, t0, h; unsigned mlo, mhi;
    DEV bool selb(int tile) const { const int blk = tile >> 1; return ((blk < 32 ? (mlo >> blk) : (mhi >> (blk - 32))) & 1u) != 0u; }
    DEV const bf16_t* kptr(int key) const { return kb + (size_t)key * 256; }
    DEV const bf16_t* vptr(int d) const { return vb + (size_t)d * 4096; }
    DEV bool skip(int tile) const { return __builtin_amdgcn_ballot_w64(selb(tile)) == 0ull; }
    DEV bool need_mask(int tile) const { return (tile * 32 + 31 > t0) || (__builtin_amdgcn_ballot_w64(!selb(tile)) != 0ull); }
    DEV Mask mask(int key0) const { return mk_mask(key0, h, 0, t, selb(key0 >> 5)); }
};
struct PolWin {
    const bf16_t* kb; const bf16_t* vb; int t, t0, h;
    DEV const bf16_t* kptr(int key) const { return kb + (size_t)key * 256; }
    DEV const bf16_t* vptr(int d) const { return vb + (size_t)d * 4096; }
    DEV bool skip(int) const { return false; }
    DEV bool need_mask(int tile) const { return (tile * 32 + 31 > t0) || (tile * 32 < t0 + 7 - 511); }
    DEV Mask mask(int key0) const { return mk_mask(key0, h, t - 511, t, true); }
};

constexpr int NSA_RING = 0, NSA_STAGE = 8192, NSA_IMP = 32768, NSA_OT = 65536, NSA_WGM = LDS_MISC + 704;
struct NsaSrc { const bf16_t* kb; const bf16_t* vb; int kstride, vstride; };
DEV void nsa_dma(const Ctx& c, const NsaSrc& s, int stage, int tile) {
    const bf16_t* src;
    if (c.wave < 4) { const int i = c.tid, r = i >> 3, cch = (i & 7) ^ (r & 7); src = s.kb + (size_t)(tile * 32 + r) * s.kstride + cch * 8; }
    else { const int i = c.tid - 256, dd = i >> 2, cch = (i & 3) ^ ((dd >> 2) & 3); src = s.vb + (size_t)dd * s.vstride + tile * 32 + cch * 8; }
    __builtin_amdgcn_global_load_lds((const unsigned*)src, (LAS unsigned*)(c.lds + NSA_RING + stage * NSA_STAGE + c.wave * 1024), 16, 0, 0);
}
DEV void nsa_frag(const Ctx& c, int stage, int r, int h, bf16x8 (&kf)[4], bf16x8 (&vf)[4]) {
    const LAS unsigned char* base = c.lds + NSA_RING + stage * NSA_STAGE;
#pragma unroll
    for (int s = 0; s < 4; ++s) kf[s] = *(const LAS bf16x8*)(base + r * 128 + (((2 * s + h) ^ (r & 7)) << 4));
    const int sw = (r >> 2) & 3;
    vf[0] = *(const LAS bf16x8*)(base + 4096 + r * 64 + (((0 + h) ^ sw) << 4));
    vf[1] = *(const LAS bf16x8*)(base + 4096 + r * 64 + (((2 + h) ^ sw) << 4));
    vf[2] = *(const LAS bf16x8*)(base + 4096 + (32 + r) * 64 + (((0 + h) ^ sw) << 4));
    vf[3] = *(const LAS bf16x8*)(base + 4096 + (32 + r) * 64 + (((2 + h) ^ sw) << 4));
}
#define NSA_WAITV(n) asm volatile("s_waitcnt vmcnt(" #n ")" ::: "memory")
#define NSA_STREAM(SRC, T0, T1, TAKE, BODY) do { \
    int tis_ = (T0); while (tis_ < (T1) && !(TAKE(tis_))) ++tis_; \
    int tu_ = tis_, infl_ = 0, si_ = 0, su_ = 0; \
    while (infl_ < 3 && tis_ < (T1)) { nsa_dma(c, SRC, si_, tis_); si_ = (si_ + 1) & 3; ++infl_; ++tis_; while (tis_ < (T1) && !(TAKE(tis_))) ++tis_; } \
    while (tu_ < (T1)) { \
        if (infl_ >= 3) NSA_WAITV(2); else if (infl_ == 2) NSA_WAITV(1); else NSA_WAITV(0); \
        __builtin_amdgcn_s_barrier(); \
        if (tis_ < (T1)) { nsa_dma(c, SRC, si_, tis_); si_ = (si_ + 1) & 3; ++infl_; ++tis_; while (tis_ < (T1) && !(TAKE(tis_))) ++tis_; } \
        BODY(tu_, su_); \
        su_ = (su_ + 1) & 3; --infl_; ++tu_; while (tu_ < (T1) && !(TAKE(tu_))) ++tu_; \
    } \
    __builtin_amdgcn_s_barrier(); } while (0)

DEV void nsa_unit(const Ctx& c, int b, int kvh, int P) {
    const int r = c.lane & 31, h = c.lane >> 5, ql = r >> 2, g = r & 3, w = c.wave;
    const int t0 = P * 64 + w * 8, t = t0 + ql, head = kvh * 4 + g, gtok = b * SEQ + t, bk = b * 4 + kvh;
    LAS float* lds_w = (LAS float*)(c.lds + NSA_IMP + w * 4096);
    LAS float* ot = (LAS float*)(c.lds + NSA_OT + w * 8192);
    const bf16_t* Q = c.w<bf16_t>(N_Q);
    bf16x8 qf[4];
#pragma unroll
    for (int s = 0; s < 4; ++s) qf[s] = *(const bf16x8*)(Q + (size_t)gtok * 1024 + head * 64 + 16 * s + 8 * h);
    const float* gt = c.w<float>(N_GATE) + (size_t)gtok * 48 + head * 3;
    const float g0 = gt[0], g1 = gt[1], g2 = gt[2];
    asm volatile("s_waitcnt vmcnt(0)" ::: "memory");
    const int cur = P;
    unsigned mlo, mhi, wlo, whi;
#define TAKE_ALL(t_) true
    {
        NsaSrc sc_; sc_.kb = c.w<bf16_t>(N_KCMP) + (size_t)bk * 256 * 64; sc_.vb = c.w<bf16_t>(N_VCMPT) + (size_t)bk * 64 * 256; sc_.kstride = 64; sc_.vstride = 256;
        PolCmp pc; pc.kb = sc_.kb; pc.vb = sc_.vb; pc.t = t; pc.t0 = t0; pc.h = h;
        const int ntcW = (4 * P + 3 + 31) >> 5;
        const int tmax = t0 + 7, ncmp = tmax >= 31 ? ((tmax - 31) >> 4) + 1 : 0, ntc = (ncmp + 31) >> 5;
        FlashState sc; flash_init(sc);
#define BODY_CMP(t_, st_) do { if ((t_) < ntc) { bf16x8 kf[4], vf[4]; nsa_frag(c, st_, r, h, kf, vf); const f32x16 S = qk_tile(kf, qf); \
            const bool nm = pc.need_mask(t_); flash_tile(sc, S, vf, nm, pc.mask((t_) * 32), c.lane); } } while (0)
        NSA_STREAM(sc_, 0, ntcW, TAKE_ALL, BODY_CMP);
        flash_accum<true>(sc, g0, ot, c.lane);
        if (cur < 16) { const unsigned long long mm = (1ull << (cur + 1)) - 1ull; mlo = (unsigned)mm; mhi = (unsigned)(mm >> 32); wlo = mlo; whi = mhi; }
        else {
            LAS float* GL = lds_w; LAS float* LL = lds_w + 512;
#pragma unroll
            for (int i = 0; i < 16; ++i) lds_w[c.lane + 64 * i] = 0.f;
            const float lt = sc.l + xor32_f(sc.l, c.lane);
            const float il = lt > 0.f ? fast_rcp(lt) : 0.f;
            const float mu = (sc.m == NEG_INF_F) ? 0.f : sc.m;
#define BODY_IMP(t_, st_) do { if ((t_) < ntc) { \
            const LAS unsigned char* base_ = c.lds + NSA_RING + (st_) * NSA_STAGE; bf16x8 kf[4]; \
            _Pragma("unroll") for (int s = 0; s < 4; ++s) kf[s] = *(const LAS bf16x8*)(base_ + r * 128 + (((2 * s + h) ^ (r & 7)) << 4)); \
            f32x16 S = qk_tile(kf, qf); const Mask vm = pc.mask((t_) * 32); \
            _Pragma("unroll") for (int i = 0; i < 16; ++i) S[i] = mask_ok(vm, i) ? fast_exp2(S[i] - mu) * il : 0.f; \
            _Pragma("unroll") for (int k = 0; k < 4; ++k) { \
                float gs = (S[4 * k] + S[4 * k + 1]) + (S[4 * k + 2] + S[4 * k + 3]), ls = S[4 * k + 3]; \
                gs += swz_xor<1>(gs); gs += swz_xor<2>(gs); ls += swz_xor<1>(ls); ls += swz_xor<2>(ls); \
                const int n = 8 * (t_) + 2 * k + h; \
                if (g == 0) { GL[ql * 64 + n] = gs; LL[ql * 64 + n] = ls; } } } } while (0)
            NSA_STREAM(sc_, 0, ntcW, TAKE_ALL, BODY_IMP);
            asm volatile("s_waitcnt lgkmcnt(0)" ::: "memory");
            const int qs = c.lane >> 3, part = c.lane & 7;
            float mine[8]; int cnt[8];
#pragma unroll
            for (int j = 0; j < 8; ++j) { const int n = part * 8 + j; mine[j] = GL[qs * 64 + n] + (n > 0 ? LL[qs * 64 + n - 1] : 0.f); cnt[j] = 0; }
#pragma nounroll
            for (int m = 1; m <= cur - 2; ++m) {
                const float vm = GL[qs * 64 + m] + LL[qs * 64 + m - 1];
#pragma unroll
                for (int j = 0; j < 8; ++j) { const int n = part * 8 + j; cnt[j] += (vm > mine[j] || (vm == mine[j] && m < n)) ? 1 : 0; }
            }
            unsigned byte = 0;
#pragma unroll
            for (int j = 0; j < 8; ++j) { const int n = part * 8 + j;
                const bool sel = (n == 0) || (n == cur) || (n == cur - 1) || (n >= 1 && n <= cur - 2 && cnt[j] < 13);
                byte |= sel ? (1u << j) : 0u; }
            unsigned lo = 0, hi = 0;
#pragma unroll
            for (int pp = 0; pp < 4; ++pp) { lo |= (unsigned)bperm_i(qs * 8 + pp, (int)byte) << (8 * pp); hi |= (unsigned)bperm_i(qs * 8 + 4 + pp, (int)byte) << (8 * pp); }
            mlo = (unsigned)bperm_i(ql * 8, (int)lo); mhi = (unsigned)bperm_i(ql * 8, (int)hi);
            unsigned olo = lo, ohi = hi;
            olo |= (unsigned)swz_xor_i<8>((int)olo); ohi |= (unsigned)swz_xor_i<8>((int)ohi); olo |= (unsigned)swz_xor_i<16>((int)olo); ohi |= (unsigned)swz_xor_i<16>((int)ohi);
            olo |= (unsigned)bperm_i(c.lane ^ 32, (int)olo); ohi |= (unsigned)bperm_i(c.lane ^ 32, (int)ohi);
            LAS unsigned* wgm = (LAS unsigned*)(c.lds + NSA_WGM);
            if (c.lane == 0) { wgm[2 * w] = olo; wgm[2 * w + 1] = ohi; }
            asm volatile("s_waitcnt lgkmcnt(0)" ::: "memory");
            __builtin_amdgcn_s_barrier();
            unsigned a = 0, bb = 0;
#pragma unroll
            for (int q = 0; q < 8; ++q) { a |= wgm[2 * q]; bb |= wgm[2 * q + 1]; }
            wlo = (unsigned)uni((int)a); whi = (unsigned)uni((int)bb);
        }
    }
    {
        NsaSrc ss_; ss_.kb = c.w<bf16_t>(N_KS) + (size_t)b * SEQ * 256 + kvh * 64; ss_.vb = c.w<bf16_t>(N_VTS) + (size_t)bk * 64 * 4096; ss_.kstride = 256; ss_.vstride = 4096;
        PolSel ps; ps.kb = ss_.kb; ps.vb = ss_.vb; ps.t = t; ps.t0 = t0; ps.h = h; ps.mlo = mlo; ps.mhi = mhi;
        FlashState ss; flash_init(ss);
        const int nts = ((t0 + 7) >> 5) + 1;
#define TAKE_SEL(t_) ((((t_) >> 1) < 32 ? (wlo >> ((t_) >> 1)) : (whi >> (((t_) >> 1) - 32))) & 1u)
#define BODY_SEL(t_, st_) do { if ((t_) < nts && !ps.skip(t_)) { bf16x8 kf[4], vf[4]; nsa_frag(c, st_, r, h, kf, vf); const f32x16 S = qk_tile(kf, qf); \
            const bool nm = ps.need_mask(t_); flash_tile(ss, S, vf, nm, ps.mask((t_) * 32), c.lane); } } while (0)
        NSA_STREAM(ss_, 0, 2 * P + 2, TAKE_SEL, BODY_SEL);
        flash_accum<false>(ss, g1, ot, c.lane);
    }
    {
        NsaSrc sw_; sw_.kb = c.w<bf16_t>(N_KW) + (size_t)b * SEQ * 256 + kvh * 64; sw_.vb = c.w<bf16_t>(N_VTW) + (size_t)bk * 64 * 4096; sw_.kstride = 256; sw_.vstride = 4096;
        PolWin pw; pw.kb = sw_.kb; pw.vb = sw_.vb; pw.t = t; pw.t0 = t0; pw.h = h;
        FlashState sw; flash_init(sw);
        const int wlo_t = (t0 - 511 > 0 ? t0 - 511 : 0) >> 5, whi_t = (t0 + 7) >> 5;
        const int W0 = (P * 64 - 511 > 0 ? P * 64 - 511 : 0) >> 5;
#define BODY_WIN(t_, st_) do { if ((t_) >= wlo_t && (t_) <= whi_t) { bf16x8 kf[4], vf[4]; nsa_frag(c, st_, r, h, kf, vf); const f32x16 S = qk_tile(kf, qf); \
            const bool nm = pw.need_mask(t_); flash_tile(sw, S, vf, nm, pw.mask((t_) * 32), c.lane); } } while (0)
        NSA_STREAM(sw_, W0, 2 * P + 2, TAKE_ALL, BODY_WIN);
        flash_accum<false>(sw, g2, ot, c.lane);
    }
    f32x16 ot0, ot1;
#pragma unroll
    for (int i = 0; i < 16; ++i) { ot0[i] = ot[i * 64 + c.lane]; ot1[i] = ot[(16 + i) * 64 + c.lane]; }
    store_o(c.w<bf16_t>(N_O) + (size_t)gtok * 1024 + head * 64, ot0, ot1, h);
}

DEV void nsa_attn_phase() {
    const Ctx c = make_ctx();
    for (int I = c.vcu; I < 2048; I += c.G) {
        int bk, P;
        if (c.G == 256) { const int x = c.vcu >> 5, l = c.vcu & 31, j = I >> 8, I2 = j * 32 + l; bk = 4 * x + (I2 & 3); const int pi = I2 >> 2; P = (j & 1) ? (8 * j + 7 - (pi & 7)) : pi; }
        else { bk = I & 31; P = I >> 5; }
        nsa_unit(c, bk >> 2, bk & 3, P);
    }
    asm volatile("s_waitcnt vmcnt(0)" ::: "memory");
    __syncthreads();
}

DEV void nsa_cmp2_phase() {
    const Ctx c = make_ctx();
    const bf16_t* HC = c.w<bf16_t>(N_HC); const bf16_t* W2 = c.w<bf16_t>(WS_WMIX) + NW_W2;
    bf16_t* KC = c.w<bf16_t>(N_KCMP); bf16_t* VT = c.w<bf16_t>(N_VCMPT);
    const int r = c.lane & 31, h = c.lane >> 5, NW = c.G * NWAVE, wg = c.vcu * NWAVE + c.wave;
    for (int u = wg; u < 512; u += NW) {
        const int row0 = u * 32, which = row0 >> 13;
        const bf16_t* w2 = W2 + (size_t)which * 64 * 256;
        f32x16 a0, a1;
#pragma unroll
        for (int i = 0; i < 16; ++i) { a0[i] = 0.f; a1[i] = 0.f; }
        const bf16_t* ap = HC + (size_t)(row0 + r) * 256 + 8 * h;
#pragma unroll 4
        for (int ks = 0; ks < 16; ++ks) {
            const bf16x8 af = *(const bf16x8*)(ap + ks * 16);
            const bf16x8 b0 = *(const bf16x8*)(w2 + (size_t)r * 256 + ks * 16 + 8 * h);
            const bf16x8 b1 = *(const bf16x8*)(w2 + (size_t)(32 + r) * 256 + ks * 16 + 8 * h);
            a0 = __builtin_amdgcn_mfma_f32_32x32x16_bf16(af, b0, a0, 0, 0, 0);
            a1 = __builtin_amdgcn_mfma_f32_32x32x16_bf16(af, b1, a1, 0, 0, 0);
        }
        const int R = row0 & 8191, bkk = R >> 8, c0 = R & 255;
        if (which == 0) {
#pragma unroll
            for (int i = 0; i < 16; ++i) { const int cc = c0 + (i & 3) + 8 * (i >> 2) + 4 * h;
                KC[((size_t)bkk * 256 + cc) * 64 + r] = f2bf(a0[i]); KC[((size_t)bkk * 256 + cc) * 64 + 32 + r] = f2bf(a1[i]); }
        } else {
#pragma unroll
            for (int a = 0; a < 4; ++a) { const int cc = c0 + 8 * a + 4 * h;
                const int pos = (cc & ~15) + 8 * ((cc >> 2) & 1) + 4 * ((cc >> 3) & 1);
                u32x2 w; w.x = cvt_pk_bf16(a0[4 * a], a0[4 * a + 1]); w.y = cvt_pk_bf16(a0[4 * a + 2], a0[4 * a + 3]);
                *(u32x2*)(VT + ((size_t)bkk * 64 + r) * 256 + pos) = w;
                u32x2 x; x.x = cvt_pk_bf16(a1[4 * a], a1[4 * a + 1]); x.y = cvt_pk_bf16(a1[4 * a + 2], a1[4 * a + 3]);
                *(u32x2*)(VT + ((size_t)bkk * 64 + 32 + r) * 256 + pos) = x; }
        }
    }
}

struct PolDil {
    const bf16_t* kb; const bf16_t* vb; int u, u0, h, kstride;
    DEV const bf16_t* kptr(int key) const { return kb + (size_t)key * kstride; }
    DEV const bf16_t* vptr(int d) const { return vb + (size_t)d * 4096; }
    DEV bool skip(int) const { return false; }
    DEV bool need_mask(int tile) const { return (tile * 32 + 31 > u0) || (tile * 32 < u0 + 31 - 128); }
    DEV Mask mask(int key0) const { return mk_mask(key0, h, u - 128, u, true); }
};
DEV void dil_attn_phase() {
    const Ctx c = make_ctx();
    const int r = c.lane & 31, h = c.lane >> 5, NW = c.G * NWAVE, wg = c.vcu * NWAVE + c.wave;
    for (int I = wg; I < 3 * 16384; I += NW) {
        const int g = I >> 14, J = I & 16383, bh = J >> 7, W = J & 127, b = bh >> 4, head = bh & 15;
        const int sh = 2 * g, L = SEQ >> sh, nub = L >> 5;
        const int rc = W / nub, ublk = W - rc * nub;
        const int u0 = ublk * 32, u = u0 + r, tok = b * SEQ + (u << sh) + rc;
        const bf16_t* Qd = c.w<bf16_t>(D_Q) + (size_t)g * NTOK * 1024;
        bf16x8 qf[4];
#pragma unroll
        for (int s = 0; s < 4; ++s) qf[s] = *(const bf16x8*)(Qd + (size_t)tok * 1024 + head * 64 + 16 * s + 8 * h);
        PolDil pd; pd.kb = c.w<bf16_t>(D_K) + (size_t)g * NTOK * 1024 + ((size_t)b * SEQ + rc) * 1024 + head * 64; pd.kstride = 1024 << sh;
        pd.vb = c.w<bf16_t>(D_VT) + ((size_t)((g * 8 + b) * 16 + head) * 64) * 4096 + rc * L; pd.u = u; pd.u0 = u0; pd.h = h;
        FlashState st; flash_init(st);
        flash_run(pd, qf, st, (ublk > 4 ? ublk - 4 : 0), ublk + 1, r, h);
        const float lt = st.l + xor32_f(st.l, c.lane);
        const float sc = fast_rcp(lt);
        f32x16 o0, o1;
#pragma unroll
        for (int i = 0; i < 16; ++i) { o0[i] = st.o0[i] * sc; o1[i] = st.o1[i] * sc; }
        store_o(c.w<bf16_t>(D_OG) + (size_t)g * NTOK * 1024 + (size_t)tok * 1024 + head * 64, o0, o1, h);
        if (h == 0) c.w<float>(D_LSE)[(size_t)g * NTOK * 16 + (size_t)tok * 16 + head] = st.m + __log2f(lt);
    }
}
DEV void dil_merge_phase() {
    const Ctx c = make_ctx();
    const bf16_t* OG = c.w<bf16_t>(D_OG); const float* LS = c.w<float>(D_LSE); bf16_t* O = c.w<bf16_t>(D_O);
    for (size_t i = (size_t)c.vcu * NTHR + c.tid; i < (size_t)NTOK * 128; i += (size_t)c.G * NTHR) {
        const size_t tok = i >> 7; const int chunk = (int)(i & 127), head = chunk >> 3;
        const float l0 = LS[tok * 16 + head], l1 = LS[(size_t)NTOK * 16 + tok * 16 + head], l2 = LS[(size_t)2 * NTOK * 16 + tok * 16 + head];
        const float mx = fmaxf(l0, fmaxf(l1, l2));
        const float e0 = fast_exp2(l0 - mx), e1 = fast_exp2(l1 - mx), e2 = fast_exp2(l2 - mx), inv = fast_rcp(e0 + e1 + e2);
        const u32x4 a = *(const u32x4*)(OG + tok * 1024 + chunk * 8), bq = *(const u32x4*)(OG + (size_t)NTOK * 1024 + tok * 1024 + chunk * 8), cq = *(const u32x4*)(OG + (size_t)2 * NTOK * 1024 + tok * 1024 + chunk * 8);
        u32x4 o;
#pragma unroll
        for (int j = 0; j < 4; ++j) {
            const float lo = (bflo(a[j]) * e0 + bflo(bq[j]) * e1 + bflo(cq[j]) * e2) * inv, hi = (bfhi(a[j]) * e0 + bfhi(bq[j]) * e1 + bfhi(cq[j]) * e2) * inv;
            o[j] = cvt_pk_bf16(lo, hi);
        }
        *(u32x4*)(O + tok * 1024 + chunk * 8) = o;
    }
}

constexpr int GL_QG = 0, GL_KG = 17408, GL_KDT = 34816, GL_VT = 53248, GL_AS = 90112, GL_ALR = 99328, GL_SEG = 103424;
DEV float logsigmoid_(float z) {
    const float e = fast_exp2(-fabsf(z) * LOG2E);
    return fminf(z, 0.f) - __log2f(1.f + e) * 0.6931471805599453f;
}
DEV void gla_a_phase(const float* w_a2, const float* b_a) {
    const Ctx c = make_ctx();
    const bf16_t* Qg = c.w<bf16_t>(G_Q); const bf16_t* Kg = c.w<bf16_t>(G_K); const float* ALR = c.w<float>(G_ALR); const bf16_t* VTg = c.w<bf16_t>(G_VT);
    float* OI = c.w<float>(G_OI); bf16_t* QGo = c.w<bf16_t>(G_QG); bf16_t* DST = c.w<bf16_t>(G_DST); float* DEC = c.w<float>(G_DEC);
    LAS bf16_t* sQG = (LAS bf16_t*)(c.lds + GL_QG); LAS bf16_t* sKG = (LAS bf16_t*)(c.lds + GL_KG);
    LAS bf16_t* sKDT = (LAS bf16_t*)(c.lds + GL_KDT);
    LAS bf16_t* sVT = (LAS bf16_t*)(c.lds + GL_VT);
    LAS bf16_t* sA = (LAS bf16_t*)(c.lds + GL_AS);
    LAS float* sALR = (LAS float*)(c.lds + GL_ALR);
    LAS float* sSEG = (LAS float*)(c.lds + GL_SEG);
    const int fr = c.lane & 15, fq = c.lane >> 4, w = c.wave;
    for (int unit = c.vcu; unit < NB * 64 * 4; unit += c.G) {
        const int hd = unit & 3, n = (unit >> 2) & 63, b = unit >> 8;
        const int tok0 = b * SEQ + n * 64;
        if (c.tid < 256) *(LAS f32x4*)(sALR + (c.tid >> 2) * 16 + (c.tid & 3) * 4) = *(const f32x4*)(ALR + (size_t)(tok0 + (c.tid >> 2)) * 16 + (c.tid & 3) * 4);
#pragma unroll
        for (int q = 0; q < 4; ++q) {
            const int id = c.tid + 512 * q, e = id >> 3, cc = (id & 7) * 8;
            *(LAS u32x4*)(sVT + e * 72 + cc) = *(const u32x4*)(VTg + ((size_t)(b * 1024 + hd * 256 + e)) * 4096 + n * 64 + cc);
        }
        __syncthreads();
        {
            const int d = c.tid & 127, seg = c.tid >> 7;
            float wa[16];
#pragma unroll
            for (int r = 0; r < 16; ++r) wa[r] = w_a2[r * 512 + hd * 128 + d];
            const float ba = b_a[hd * 128 + d];
            bf16_t qraw[16], kraw[16];
#pragma unroll
            for (int cc = 0; cc < 16; ++cc) { qraw[cc] = Qg[(size_t)(tok0 + seg * 16 + cc) * 512 + hd * 128 + d]; kraw[cc] = Kg[(size_t)(tok0 + seg * 16 + cc) * 512 + hd * 128 + d]; }
            float cum[16]; float run = 0.f;
#pragma unroll
            for (int cc = 0; cc < 16; ++cc) {
                const LAS float* ar = sALR + (seg * 16 + cc) * 16;
                float z = ba;
#pragma unroll
                for (int r = 0; r < 16; ++r) z += ar[r] * wa[r];
                run += logsigmoid_(z) * (1.f / 16.f); cum[cc] = run;
            }
            sSEG[seg * 128 + d] = run;
            __syncthreads();
            float off = 0.f, blast = 0.f;
#pragma unroll
            for (int s = 0; s < 4; ++s) { const float v = sSEG[s * 128 + d]; off += (s < seg) ? v : 0.f; blast += v; }
#pragma unroll
            for (int cc = 0; cc < 16; ++cc) {
                const int cpos = seg * 16 + cc; const float bcd = cum[cc] + off;
                const float qv = bf2f(qraw[cc]), kv = bf2f(kraw[cc]);
                const float eb = fast_exp2(bcd * LOG2E);
                const bf16_t qg = f2bf(qv * eb * 0.08838834764831845f), kg = f2bf(kv * fast_rcp(eb)), kd = f2bf(kv * fast_exp2((blast - bcd) * LOG2E));
                sQG[cpos * 136 + d] = qg; sKG[cpos * 136 + d] = kg; sKDT[d * 72 + cpos] = kd;
                QGo[(size_t)(tok0 + cpos) * 512 + hd * 128 + d] = qg;
            }
            if (seg == 0) DEC[((size_t)((b * 64 + n) * 4 + hd)) * 128 + d] = fast_exp2(blast * LOG2E);
        }
        __syncthreads();
        {
            const int it = w >> 1;
#pragma unroll
            for (int jj = 0; jj < 2; ++jj) {
                const int jt = 2 * (w & 1) + jj;
                f32x4 acc = {0.f, 0.f, 0.f, 0.f};
#pragma unroll
                for (int ks = 0; ks < 4; ++ks) {
                    const bf16x8 a = *(const LAS bf16x8*)(sKG + (jt * 16 + fr) * 136 + ks * 32 + fq * 8);
                    const bf16x8 bq = *(const LAS bf16x8*)(sQG + (it * 16 + fr) * 136 + ks * 32 + fq * 8);
                    acc = __builtin_amdgcn_mfma_f32_16x16x32_bf16(a, bq, acc, 0, 0, 0);
                }
                const int i = it * 16 + fr, j0 = jt * 16 + fq * 4;
                u32x2 wv; wv.x = cvt_pk_bf16(i >= j0 ? acc[0] : 0.f, i >= j0 + 1 ? acc[1] : 0.f); wv.y = cvt_pk_bf16(i >= j0 + 2 ? acc[2] : 0.f, i >= j0 + 3 ? acc[3] : 0.f);
                *(LAS u32x2*)(sA + i * 72 + j0) = wv;
            }
        }
        __syncthreads();
        {
            const int e0 = w * 32;
            f32x4 acc[2][4];
#pragma unroll
            for (int et = 0; et < 2; ++et)
#pragma unroll
                for (int it = 0; it < 4; ++it) acc[et][it] = (f32x4){0.f, 0.f, 0.f, 0.f};
#pragma unroll
            for (int ks = 0; ks < 2; ++ks) {
                bf16x8 bi[4];
#pragma unroll
                for (int it = 0; it < 4; ++it) bi[it] = *(const LAS bf16x8*)(sA + (it * 16 + fr) * 72 + ks * 32 + fq * 8);
#pragma unroll
                for (int et = 0; et < 2; ++et) {
                    const bf16x8 a = *(const LAS bf16x8*)(sVT + (e0 + et * 16 + fr) * 72 + ks * 32 + fq * 8);
#pragma unroll
                    for (int it = 0; it < 4; ++it) acc[et][it] = __builtin_amdgcn_mfma_f32_16x16x32_bf16(a, bi[it], acc[et][it], 0, 0, 0);
                }
            }
#pragma unroll
            for (int et = 0; et < 2; ++et)
#pragma unroll
                for (int it = 0; it < 4; ++it)
                    *(f32x4*)(OI + (size_t)(tok0 + it * 16 + fr) * 1024 + hd * 256 + e0 + et * 16 + fq * 4) = acc[et][it];
        }
        {
            const int e0 = w * 32;
#pragma unroll
            for (int et = 0; et < 2; ++et) {
                f32x4 acc[8];
#pragma unroll
                for (int dt = 0; dt < 8; ++dt) acc[dt] = (f32x4){0.f, 0.f, 0.f, 0.f};
#pragma unroll
                for (int ks = 0; ks < 2; ++ks) {
                    const bf16x8 bq = *(const LAS bf16x8*)(sVT + (e0 + et * 16 + fr) * 72 + ks * 32 + fq * 8);
#pragma unroll
                    for (int dt = 0; dt < 8; ++dt) {
                        const bf16x8 a = *(const LAS bf16x8*)(sKDT + (dt * 16 + fr) * 72 + ks * 32 + fq * 8);
                        acc[dt] = __builtin_amdgcn_mfma_f32_16x16x32_bf16(a, bq, acc[dt], 0, 0, 0);
                    }
                }
                bf16_t* dp = DST + (((size_t)((b * 4 + hd) * 64 + n)) * 256 + e0 + et * 16 + fr) * 128 + fq * 4;
#pragma unroll
                for (int dt = 0; dt < 8; ++dt) { u32x2 wv; wv.x = cvt_pk_bf16(acc[dt][0], acc[dt][1]); wv.y = cvt_pk_bf16(acc[dt][2], acc[dt][3]); *(u32x2*)(dp + dt * 16) = wv; }
            }
        }
        __syncthreads();
    }
}

DEV void gla_b_phase() {
    const Ctx c = make_ctx();
    float* OI = c.w<float>(G_OI); const bf16_t* QG = c.w<bf16_t>(G_QG); const bf16_t* DST = c.w<bf16_t>(G_DST); const float* DEC = c.w<float>(G_DEC);
    const int fr = c.lane & 15, fq = c.lane >> 4, NW = c.G * NWAVE, wg = c.vcu * NWAVE + c.wave;
    for (int I = wg; I < 2048; I += NW) {
        const int it = I & 3, et = (I >> 2) & 15, hd = (I >> 6) & 3, b = I >> 8;
        float S[4][8];
#pragma unroll
        for (int ks = 0; ks < 4; ++ks)
#pragma unroll
            for (int j = 0; j < 8; ++j) S[ks][j] = 0.f;
        const bf16_t* qp = QG + (size_t)(b * SEQ + it * 16 + fr) * 512 + hd * 128 + fq * 8;
        const bf16_t* dp = DST + (((size_t)(b * 4 + hd) * 64) * 256 + et * 16 + fr) * 128 + fq * 8;
        const float* cp = DEC + ((size_t)(b * 64) * 4 + hd) * 128 + fq * 8;
        float* op = OI + (size_t)(b * SEQ + it * 16 + fq * 4) * 1024 + hd * 256 + et * 16 + fr;
        bf16x8 qa[4], qb[4]; u32x4 da[4], db[4]; f32x4 ca[4][2], cb[4][2]; float oa[4], ob[4];
#define GLB_LOAD(n_, QF, DS, DC, OI) do { _Pragma("unroll") for (int ks = 0; ks < 4; ++ks) { \
            QF[ks] = *(const bf16x8*)(qp + (size_t)(n_) * 64 * 512 + ks * 32); \
            DS[ks] = *(const u32x4*)(dp + (size_t)(n_) * 256 * 128 + ks * 32); \
            DC[ks][0] = *(const f32x4*)(cp + (size_t)(n_) * 512 + ks * 32); DC[ks][1] = *(const f32x4*)(cp + (size_t)(n_) * 512 + ks * 32 + 4); } \
            _Pragma("unroll") for (int r = 0; r < 4; ++r) OI[r] = op[(size_t)((n_) * 64 + r) * 1024]; } while (0)
#define GLB_STEP(n_, QF, DS, DC, OI) do { f32x4 acc = {0.f, 0.f, 0.f, 0.f}; \
            _Pragma("unroll") for (int ks = 0; ks < 4; ++ks) { \
                u32x4 sw; sw.x = cvt_pk_bf16(S[ks][0], S[ks][1]); sw.y = cvt_pk_bf16(S[ks][2], S[ks][3]); sw.z = cvt_pk_bf16(S[ks][4], S[ks][5]); sw.w = cvt_pk_bf16(S[ks][6], S[ks][7]); \
                acc = __builtin_amdgcn_mfma_f32_16x16x32_bf16(QF[ks], __builtin_bit_cast(bf16x8, sw), acc, 0, 0, 0); } \
            _Pragma("unroll") for (int r = 0; r < 4; ++r) op[(size_t)((n_) * 64 + r) * 1024] = OI[r] + acc[r]; \
            _Pragma("unroll") for (int ks = 0; ks < 4; ++ks) _Pragma("unroll") for (int j = 0; j < 4; ++j) { \
                S[ks][2 * j] = DC[ks][j >> 1][(2 * j) & 3] * S[ks][2 * j] + bflo(DS[ks][j]); \
                S[ks][2 * j + 1] = DC[ks][j >> 1][(2 * j + 1) & 3] * S[ks][2 * j + 1] + bfhi(DS[ks][j]); } } while (0)
        GLB_LOAD(0, qa, da, ca, oa);
#pragma nounroll
        for (int n = 0; n < 64; n += 2) {
            GLB_LOAD(n + 1, qb, db, cb, ob);
            GLB_STEP(n, qa, da, ca, oa);
            if (n + 2 < 64) GLB_LOAD(n + 2, qa, da, ca, oa);
            GLB_STEP(n + 1, qb, db, cb, ob);
        }
#undef GLB_LOAD
#undef GLB_STEP
    }
}

DEV void gla_c_phase(const float* norm_g) {
    const Ctx c = make_ctx();
    const float* OI = c.w<float>(G_OI); const bf16_t* R = c.w<bf16_t>(G_R); bf16_t* GO = c.w<bf16_t>(G_O);
    const f32x4 gv = *(const f32x4*)(norm_g + c.lane * 4);
    const int NW = c.G * NWAVE, wg = c.vcu * NWAVE + c.wave;
    for (int I = wg; I < NTOK * 4; I += NW) {
        const size_t off = (size_t)(I >> 2) * 1024 + (I & 3) * 256 + c.lane * 4;
        const f32x4 v = *(const f32x4*)(OI + off);
        const float ss = wave_sum((v[0] * v[0] + v[1] * v[1]) + (v[2] * v[2] + v[3] * v[3]), c.lane);
        const float rs = __builtin_amdgcn_rsqf(ss * (1.f / 256.f) + LN_EPS);
        const u32x2 rw = *(const u32x2*)(R + off);
        u32x2 o; o.x = cvt_pk_bf16(v[0] * rs * gv[0] * bflo(rw.x), v[1] * rs * gv[1] * bfhi(rw.x)); o.y = cvt_pk_bf16(v[2] * rs * gv[2] * bflo(rw.y), v[3] * rs * gv[3] * bfhi(rw.y));
        *(u32x2*)(GO + off) = o;
    }
}

enum { S_END = 0, S_CONV_NSA, S_CMP2, S_NSA_ATTN, S_CONV_GLA, S_GLA_A, S_GLA_B, S_GLA_C, S_CONV_DIL, S_DIL_ATTN, S_DIL_MERGE, S_LN1, S_ROUTE_A, S_ROUTE_B, S_LN2,
       S_GEMM0 = 32, S_G_NSA_A = 32, S_G_NSA_V, S_G_CMP1, S_G_WOUT_N, S_G_GLA_A, S_G_GLA_V, S_G_WOUT_G, S_G_DIL_A, S_G_DIL_V, S_G_WOUT_D, S_G_MOE1, S_G_MOE2 };
__device__ const unsigned char STEPS[3][16] = {
    {S_CONV_NSA, S_G_NSA_A, S_G_NSA_V, S_G_CMP1, S_CMP2, S_NSA_ATTN, S_G_WOUT_N, S_LN1, S_ROUTE_A, S_ROUTE_B, S_G_MOE1, S_G_MOE2, S_LN2, S_END, S_END, S_END},
    {S_CONV_GLA, S_G_GLA_A, S_G_GLA_V, S_GLA_A, S_GLA_B, S_GLA_C, S_G_WOUT_G, S_LN1, S_ROUTE_A, S_ROUTE_B, S_G_MOE1, S_G_MOE2, S_LN2, S_END, S_END, S_END},
    {S_CONV_DIL, S_G_DIL_A, S_G_DIL_V, S_DIL_ATTN, S_DIL_MERGE, S_G_WOUT_D, S_LN1, S_ROUTE_A, S_ROUTE_B, S_G_MOE1, S_G_MOE2, S_LN2, S_END, S_END, S_END, S_END},
};

DEV void cmp_bias(const float* pos0, const float* w10, const float* pos1, const float* w11) {
    const Ctx c = make_ctx();
    float* bias = c.w<float>(WS_BIAS);
    LAS float* red = (LAS float*)(c.lds + 65536);
    for (int u = c.vcu; u < 64; u += c.G) {
        const int which = u >> 5, j = (u & 31) * 8 + (c.tid & 7), kl = c.tid >> 3;
        const float* pos = which ? pos1 : pos0; const float* w1 = which ? w11 : w10;
        float s = 0.f;
#pragma unroll 8
        for (int i = 0; i < 32; ++i) { const int k = kl + 64 * i; s += pos[k] * w1[(size_t)k * 256 + j]; }
        red[c.tid] = s;
        __syncthreads();
        if (c.tid < 8) { float t = 0.f; for (int q = 0; q < 64; ++q) t += red[q * 8 + c.tid]; bias[which * 256 + (u & 31) * 8 + c.tid] = t; }
        __syncthreads();
    }
}

DEV void conv_moe(int lb  ) {
    int rot = 0;
    const Ctx c = make_ctx();
    ConvJob j;
    j.src = c.in(lb + 4); j.dst = c.w<bf16_t>(WS_WE1); j.ldn = 512; j.K = 1024; j.ntn = 8; j.nvalid = 512; j.nbatch = 64; j.sbatch = (size_t)1024 * 512; j.dbatch = (size_t)512 * 1024; j.mode = 1; j.col0 = 0;
    rot = conv_run(j, rot);
    j.src = c.in(lb + 6); j.dst = c.w<bf16_t>(WS_WE1) + (size_t)64 * 512 * 1024; j.nbatch = 1;
    rot = conv_run(j, rot);
    j.src = c.in(lb + 5); j.dst = c.w<bf16_t>(WS_WE2); j.ldn = 1024; j.K = 256; j.ntn = 16; j.nvalid = 1024; j.nbatch = 64; j.sbatch = (size_t)256 * 1024; j.dbatch = (size_t)1024 * 256; j.mode = 0; j.col0 = 0;
    rot = conv_run(j, rot);
    j.src = c.in(lb + 7); j.dst = c.w<bf16_t>(WS_WE2) + (size_t)64 * 1024 * 256; j.nbatch = 1;
    rot = conv_run(j, rot);
    conv_router(c.in(lb + 2), c.w<bf16_t>(WS_WR));
}

static_assert(sizeof(GemmDesc) <= 192, "GemmDesc slot");
DEV void gemm_table() {
    const Ctx c = make_ctx();
    if (c.tid < 12) {
        const int step = S_GEMM0 + c.tid;
        bf16_t* XB = c.w<bf16_t>(WS_XB); bf16_t* WM = c.w<bf16_t>(WS_WMIX); int* meta = c.w<int>(WS_META);
        LAS GemmDesc& d = *(LAS GemmDesc*)(c.lds + LDS_DESC + c.tid * 192);
        d.lda = 1024; d.ldb = 1024; d.K = 1024; d.kstepA = 64; d.nM = 128; d.nN = 4; d.nM_ptr = nullptr; d.amode = AM_ID; d.aidx = nullptr; d.bmode = BM_ID; d.tile_e = nullptr; d.bstride = 0;
        d.o0 = XB; d.o1 = nullptr; d.o2 = nullptr; d.o3 = nullptr; d.f0 = nullptr; d.f1 = nullptr; d.A = XB; d.Bt = WM; d.epi = EPI_WOUT;
        switch (step) {
        case S_G_NSA_A: d.Bt = WM + NW_A; d.nN = 9; d.epi = EPI_NSA_A; d.o0 = c.w<void>(N_Q); d.o1 = c.w<void>(N_KCVC); d.o2 = c.w<void>(N_GATE); break;
        case S_G_NSA_V: d.A = WM + NW_V; d.Bt = XB; d.nM = 2; d.nN = 128; d.epi = EPI_NSA_V; d.o0 = c.w<void>(N_VTS); break;
        case S_G_CMP1:  d.A = c.w<bf16_t>(N_KCVC); d.lda = 16 * 256; d.kstepA = 256; d.amode = AM_CMP; d.K = 2048; d.Bt = WM + NW_W1; d.ldb = 2048; d.bmode = BM_EXP; d.tile_e = meta + META_TILE + 1280; d.bstride = (size_t)256 * 2048;
                        d.nM = 64; d.nN = 1; d.epi = EPI_CMP1; d.o0 = c.w<void>(N_HC); d.f0 = c.w<float>(WS_BIAS); break;
        case S_G_WOUT_N: d.A = c.w<bf16_t>(N_O); d.Bt = WM + NW_OUT; d.o0 = XB; break;
        case S_G_GLA_A: d.Bt = WM + GW_A; d.nN = 9; d.epi = EPI_GLA_A; d.o0 = c.w<void>(G_Q); d.o1 = c.w<void>(G_R); d.o2 = c.w<void>(G_ALR); break;
        case S_G_GLA_V: d.A = WM + GW_V; d.Bt = XB; d.nM = 4; d.nN = 128; d.epi = EPI_GLA_V; d.o0 = c.w<void>(G_VT); break;
        case S_G_WOUT_G: d.A = c.w<bf16_t>(G_O); d.Bt = WM + GW_OUT; d.o0 = XB; break;
        case S_G_DIL_A: d.Bt = WM + DW_A; d.nN = 24; d.epi = EPI_DIL_A; d.o0 = c.w<void>(D_Q); d.o1 = c.w<void>(D_K); break;
        case S_G_DIL_V: d.A = WM + DW_V; d.Bt = XB; d.nM = 12; d.nN = 128; d.bmode = BM_DIL; d.epi = EPI_DIL_V; d.o0 = c.w<void>(D_VT); break;
        case S_G_WOUT_D: d.A = c.w<bf16_t>(D_O); d.Bt = WM + DW_OUT; d.o0 = XB; break;
        case S_G_MOE1:  d.A = XB; d.amode = AM_IDX; d.aidx = c.w<int>(A_ROWTOK); d.Bt = c.w<bf16_t>(WS_WE1); d.bmode = BM_EXP; d.tile_e = meta + META_TILE; d.bstride = (size_t)512 * 1024;
                        d.nM_ptr = meta + META_NMT; d.nN = 2; d.epi = EPI_MOE1; d.o0 = c.w<void>(A_H); break;
        case S_G_MOE2:  d.A = c.w<bf16_t>(A_H); d.lda = 256; d.K = 256; d.Bt = c.w<bf16_t>(WS_WE2); d.ldb = 256; d.bmode = BM_EXP; d.tile_e = meta + META_TILE; d.bstride = (size_t)1024 * 256;
                        d.nM_ptr = meta + META_NMT; d.nN = 4; d.epi = EPI_MOE2; d.o0 = c.w<void>(A_Y); d.o1 = XB; d.o2 = c.w<void>(A_ROWTOK); d.f0 = c.w<float>(A_ROWGATE); break;
        default: break;
        }
    }
    __syncthreads();
}

DEV void conv_nsa(int mb) {
    const Ctx c = make_ctx(); bf16_t* WM = c.w<bf16_t>(WS_WMIX); int rot = 0;
    const float* win = c.in(mb);
    rot = conv(win, 2608, 0, 1280, 1280, 1024, WM + NW_A, rot);
    rot = conv(win, 2608, 1280, 256, 256, 1024, WM + NW_A + (size_t)1280 * 1024, rot);
    rot = conv(win, 2608, 1536, 256, 256, 1024, WM + NW_A + (size_t)1536 * 1024, rot);
    rot = conv(win, 2608, 2048, 256, 256, 1024, WM + NW_A + (size_t)1792 * 1024, rot);
    rot = conv(win, 2608, 2560, 48, 256, 1024, WM + NW_A + (size_t)2048 * 1024, rot);
    rot = conv(win, 2608, 1792, 256, 256, 1024, WM + NW_V, rot);
    rot = conv(win, 2608, 2304, 256, 256, 1024, WM + NW_V + (size_t)256 * 1024, rot);
    rot = conv(c.in(mb + 3), 256, 0, 256, 256, 2048, WM + NW_W1, rot);
    rot = conv(c.in(mb + 6), 256, 0, 256, 256, 2048, WM + NW_W1 + (size_t)256 * 2048, rot);
    rot = conv(c.in(mb + 1), 1024, 0, 1024, 1024, 1024, WM + NW_OUT, rot);
    rot = conv(c.in(mb + 4), 64, 0, 64, 64, 256, WM + NW_W2, rot);
    rot = conv(c.in(mb + 7), 64, 0, 64, 64, 256, WM + NW_W2 + (size_t)64 * 256, rot);
    cmp_bias(c.in(mb + 2), c.in(mb + 3), c.in(mb + 5), c.in(mb + 6));
}
DEV void conv_gla(int mb) {
    const Ctx c = make_ctx(); bf16_t* WM = c.w<bf16_t>(WS_WMIX); int rot = 0;
    const float* win = c.in(mb);
    rot = conv(win, 3088, 0, 1024, 1024, 1024, WM + GW_A, rot);
    rot = conv(win, 3088, 2064, 1024, 1024, 1024, WM + GW_A + (size_t)1024 * 1024, rot);
    rot = conv(win, 3088, 2048, 16, 256, 1024, WM + GW_A + (size_t)2048 * 1024, rot);
    rot = conv(win, 3088, 1024, 1024, 1024, 1024, WM + GW_V, rot);
    rot = conv(c.in(mb + 4), 1024, 0, 1024, 1024, 1024, WM + GW_OUT, rot);
}
DEV void conv_dil(int mb) {
    const Ctx c = make_ctx(); bf16_t* WM = c.w<bf16_t>(WS_WMIX); int rot = 0;
    const float* win = c.in(mb);
    for (int g = 0; g < 3; ++g) {
        rot = conv(win, 9216, g * 3072, 2048, 2048, 1024, WM + DW_A + (size_t)g * 2048 * 1024, rot);
        rot = conv(win, 9216, g * 3072 + 2048, 1024, 1024, 1024, WM + DW_V + (size_t)g * 1024 * 1024, rot);
    }
    rot = conv(c.in(mb + 1), 1024, 0, 1024, 1024, 1024, WM + DW_OUT, rot);
}
DEV const float* inptr(int i) { const Ctx c = make_ctx(); return c.in(i); }

__global__ void __launch_bounds__(NTHR, 2) fwd(Args args) {
    extern __shared__ __attribute__((aligned(16))) unsigned char lds_raw[];
    LAS unsigned char* lds = (LAS unsigned char*)lds_raw;
    if (threadIdx.x < 4) ((LAS unsigned*)(lds + LDS_MISC))[threadIdx.x] = 0u;
    if (threadIdx.x == 0) {
        *(unsigned char* LAS*)(lds + LDS_MISC + 16) = args.ws; *(float* LAS*)(lds + LDS_MISC + 24) = args.out;
#pragma unroll
        for (int i = 0; i < 64; ++i) ((const float* LAS*)(lds + LDS_MISC + 64))[i] = args.in[i];
    }
    __syncthreads();
    { const Ctx c = make_ctx(); (void)xcd_barrier_post((unsigned*)c.ws + CW_BAR, (volatile LAS unsigned*)(lds + LDS_MISC));
      if (c.vcu == 0 && c.tid < 64) c.w<int>(WS_META)[META_TILE + 1280 + c.tid] = c.tid >> 5;
      if (c.tid == 0) { *(LAS int*)(lds + LDS_MISC + 32) = 0; *(LAS int*)(lds + LDS_MISC + 40) = 0;
#ifdef PROBE_T
        volatile LAS unsigned long long* T = (volatile LAS unsigned long long*)(lds + LDS_MISC + 600); T[0] = __builtin_amdgcn_s_memrealtime(); T[1] = 0;
#endif
      } }
    gemm_table();
    prologue();
    for (;;) {
        __syncthreads();
        int pc = *(volatile LAS int*)(lds + LDS_MISC + 32);
        pc = __builtin_amdgcn_readfirstlane(pc);
        const int L = pc >> 4, si = pc & 15;
        if (L >= 4) break;
        const int kind = (L == 3) ? 0 : L;
        const int mb = (L == 0) ? 1 : (L == 1) ? 19 : (L == 2) ? 34 : 46;
        const int lb = (L == 0) ? 9 : (L == 1) ? 24 : (L == 2) ? 36 : 54;
        const int step = STEPS[kind][si];
        __syncthreads();
#ifdef REPEAT_MASK
        if (threadIdx.x == 0) {
            volatile LAS int* rep = (volatile LAS int*)(lds + LDS_MISC + 40);
            const bool again = (step != S_END) && ((REPEAT_MASK >> step) & 1ull) && (*rep == 0);
            *rep = again ? 1 : 0;
            *(volatile LAS int*)(lds + LDS_MISC + 32) = again ? pc : ((step == S_END || si == 15) ? (L + 1) * 16 : pc + 1);
        }
#else
        if (threadIdx.x == 0) *(volatile LAS int*)(lds + LDS_MISC + 32) = (step == S_END || si == 15) ? (L + 1) * 16 : pc + 1;
#endif
        if (step == S_END) continue;
        if (step >= S_GEMM0) gemm_phase(step - S_GEMM0);
        else {
            switch (step) {
            case S_CONV_NSA: conv_nsa(mb); break;
            case S_CMP2: nsa_cmp2_phase(); break;
            case S_NSA_ATTN: nsa_attn_phase(); break;
            case S_CONV_GLA: conv_gla(mb); break;
            case S_GLA_A: gla_a_phase(inptr(mb + 1), inptr(mb + 2)); break;
            case S_GLA_B: gla_b_phase(); break;
            case S_GLA_C: gla_c_phase(inptr(mb + 3)); break;
            case S_CONV_DIL: conv_dil(mb); break;
            case S_DIL_ATTN: dil_attn_phase(); break;
            case S_DIL_MERGE: dil_merge_phase(); break;
            case S_LN1: ln_phase<0>(inptr(lb), inptr(lb + 1), nullptr); conv_moe(lb); break;
            case S_ROUTE_A: route_a(inptr(lb + 3)); break;
            case S_ROUTE_B: route_b(); break;
            case S_LN2: { const Ctx c2 = make_ctx(); ln_phase<1>(inptr(lb + 8), inptr(lb + 9), L == 3 ? c2.xf : nullptr); } break;
            default: break;
            }
        }
        { const Ctx c = make_ctx(); XcdBarrier bar; bar.bar = (unsigned*)c.ws + CW_BAR; bar.x = xb_xcc_id(); bar.st = (volatile LAS unsigned*)(c.lds + LDS_MISC); xcd_barrier(bar); }
#ifdef PROBE_T
        if (threadIdx.x == 0) {
            volatile LAS unsigned long long* T = (volatile LAS unsigned long long*)(lds + LDS_MISC + 600);
            const unsigned long long now = __builtin_amdgcn_s_memrealtime(), d = now - T[0]; T[0] = now;
            if ((PROBE_T >> step) & 1ull) T[1] += d;
        }
#endif
    }
#ifdef PROBE_T
    {
        const Ctx c = make_ctx();
        if (blockIdx.x == 0 && c.tid == 0) {
            volatile LAS unsigned long long* T = (volatile LAS unsigned long long*)(lds + LDS_MISC + 600);
            c.xf[0] += floorf((float)T[1] * (0.01f / (float)PROBE_UNIT_US));
        }
    }
#endif
}

extern "C" void kernel_launch(void* const* d_in, const int* in_sizes, int n_in, void* d_out, int out_size, void* d_ws, size_t ws_size, hipStream_t stream) {
    static int grid = 0;
    if (grid == 0) {
        if (n_in != 64 || out_size != NTOK * DM || ws_size < WS_NEED) { fprintf(stderr, "kernel_launch: unexpected problem (n_in %d, out %d, ws %zu, need %zu)\n", n_in, out_size, ws_size, (size_t)WS_NEED); grid = -1; return; }
        int dev = 0, cus = 0, per_cu = 0;
        if (hipGetDevice(&dev) != hipSuccess || hipDeviceGetAttribute(&cus, hipDeviceAttributeMultiprocessorCount, dev) != hipSuccess) { grid = -1; return; }
        if (hipFuncSetAttribute((const void*)fwd, hipFuncAttributeMaxDynamicSharedMemorySize, LDS_BYTES) != hipSuccess) { fprintf(stderr, "kernel_launch: hipFuncSetAttribute failed\n"); grid = -1; return; }
        if (hipOccupancyMaxActiveBlocksPerMultiprocessor(&per_cu, (const void*)fwd, NTHR, LDS_BYTES) != hipSuccess || per_cu < 1) { fprintf(stderr, "kernel_launch: occupancy query says %d\n", per_cu); }
        (void)hipGetLastError();
        grid = cus;
    }
    if (grid < 0) return;
    (void)in_sizes;
    if (hipMemsetAsync(d_ws, 0, CTL_BYTES, stream) != hipSuccess) return;
    Args a;
    for (int i = 0; i < 64; ++i) a.in[i] = (const float*)d_in[i];
    a.out = (float*)d_out; a.ws = (unsigned char*)d_ws;
    hipLaunchKernelGGL(fwd, dim3(grid), dim3(NTHR), LDS_BYTES, stream, a);
}
```
